# Optimizing an MI355X kernel written in HIP

```python
import math
import jax
import jax.numpy as jnp
from jax import lax
import numpy as np

D_MODEL = 1024
BATCH = 2
SEQ = 16384
DEPTH = 2

N_MIXERS = 2
HEAD_DIM = 64
N_HEADS = 12
N_KV_HEADS_B = 2
N_MEM_HEADS = 4
MEM_LEN = 256
ATTN_WIDTH = N_HEADS * HEAD_DIM
MEM_WIDTH = N_MEM_HEADS * HEAD_DIM
BRANCH_WIDTH = ATTN_WIDTH + MEM_WIDTH
KV_WIDTH_B = N_KV_HEADS_B * HEAD_DIM
IN_WIDTH_A = 3 * ATTN_WIDTH + MEM_WIDTH + BRANCH_WIDTH
IN_WIDTH_B = ATTN_WIDTH + 2 * KV_WIDTH_B + MEM_WIDTH + BRANCH_WIDTH
MOBA_BLOCK = 256
MOBA_TOPK = 3
MOBA_QCHUNK = 32
WINDOW = 128
N_LAYERS_A = (DEPTH + 1) // 2
N_LAYERS_B = DEPTH // 2
RMS_EPS = 1e-6

kernel_name = "moba_swa_sink_hybrid_trunk"


def rms_norm(x, g):
    xf = x.astype(jnp.float32)
    y = xf * lax.rsqrt(jnp.mean(xf * xf, axis=-1, keepdims=True) + RMS_EPS)
    return (y * g.astype(jnp.float32)).astype(x.dtype)


def alibi_slopes(n_heads):
    def pow2_slopes(n):
        start = 2.0 ** (-8.0 / n)
        return [start ** (i + 1) for i in range(n)]
    if math.log2(n_heads).is_integer():
        vals = pow2_slopes(n_heads)
    else:
        c = 2 ** math.floor(math.log2(n_heads))
        vals = pow2_slopes(c) + pow2_slopes(2 * c)[0::2][: n_heads - c]
    return jnp.asarray(np.array(vals, dtype=np.float32))


def moba_attention(q, k, v, slopes):
    b, s, h, dh = q.shape
    nblk = -(-s // MOBA_BLOCK)
    sp = nblk * MOBA_BLOCK
    topk = min(MOBA_TOPK, nblk)
    pad = ((0, 0), (0, sp - s), (0, 0), (0, 0))
    q = jnp.pad(q, pad).transpose(0, 2, 1, 3)
    kb = jnp.pad(k, pad).transpose(0, 2, 1, 3).reshape(b, h, nblk, MOBA_BLOCK, dh)
    vb = jnp.pad(v, pad).transpose(0, 2, 1, 3).reshape(b, h, nblk, MOBA_BLOCK, dh)
    kmean = jnp.mean(kb.astype(jnp.float32), axis=3).astype(kb.dtype)
    scale = dh ** -0.5
    bi = jnp.arange(b)[:, None, None, None]
    hi = jnp.arange(h)[None, :, None, None]
    blk_ids = jnp.arange(nblk, dtype=jnp.int32)
    offs = jnp.arange(MOBA_BLOCK, dtype=jnp.int32)
    qoffs = jnp.arange(MOBA_QCHUNK, dtype=jnp.int32)
    sl5 = slopes[None, :, None, None, None]
    sl4 = slopes[None, :, None, None]

    def chunk(c):
        start = c * MOBA_QCHUNK
        j = start // MOBA_BLOCK
        qc = lax.dynamic_slice_in_dim(q, start, MOBA_QCHUNK, axis=2)
        tpos = start + qoffs
        gate = jnp.einsum('bhqd,bhnd->bhqn', qc, kmean).astype(jnp.float32)
        gate = jnp.where(blk_ids < j, gate, -jnp.inf)
        _, idx = lax.top_k(gate, topk)
        valid = idx < j
        ksel = kb[bi, hi, idx]
        vsel = vb[bi, hi, idx]
        s_sel = jnp.einsum('bhqd,bhqkld->bhqkl', qc, ksel).astype(jnp.float32) * scale
        spos = idx[..., None] * MOBA_BLOCK + offs
        dist_sel = (tpos[None, None, :, None, None] - spos).astype(jnp.float32)
        s_sel = s_sel - sl5 * dist_sel
        s_sel = jnp.where(valid[..., None], s_sel, -jnp.inf).reshape(b, h, MOBA_QCHUNK, topk * MOBA_BLOCK)
        kown = lax.dynamic_index_in_dim(kb, j, axis=2, keepdims=False)
        vown = lax.dynamic_index_in_dim(vb, j, axis=2, keepdims=False)
        dist_own = tpos[:, None] - (j * MOBA_BLOCK + offs)[None, :]
        s_own = jnp.einsum('bhqd,bhld->bhql', qc, kown).astype(jnp.float32) * scale
        s_own = s_own - sl4 * dist_own.astype(jnp.float32)
        s_own = jnp.where(dist_own >= 0, s_own, -jnp.inf)
        p = jax.nn.softmax(jnp.concatenate([s_sel, s_own], axis=-1), axis=-1).astype(vb.dtype)
        p_sel = p[..., : topk * MOBA_BLOCK].reshape(b, h, MOBA_QCHUNK, topk, MOBA_BLOCK)
        p_own = p[..., topk * MOBA_BLOCK:]
        return (jnp.einsum('bhqkl,bhqkld->bhqd', p_sel, vsel)
                + jnp.einsum('bhql,bhld->bhqd', p_own, vown))

    n_chunks = sp // MOBA_QCHUNK
    out = lax.map(chunk, jnp.arange(n_chunks, dtype=jnp.int32))
    out = out.transpose(1, 0, 3, 2, 4).reshape(b, sp, h * dh)
    return out[:, :s]


def swa_sink_attention(q, k, v, sinks, slopes):
    b, s, hq, dh = q.shape
    hkv = k.shape[2]
    g = hq // hkv
    nb = s // WINDOW
    qb = q.reshape(b, nb, WINDOW, hkv, g, dh)
    kb = k.reshape(b, nb, WINDOW, hkv, dh)
    vb = v.reshape(b, nb, WINDOW, hkv, dh)
    padb = ((0, 0), (1, 0), (0, 0), (0, 0), (0, 0))
    kband = jnp.concatenate([jnp.pad(kb, padb)[:, :-1], kb], axis=2)
    vband = jnp.concatenate([jnp.pad(vb, padb)[:, :-1], vb], axis=2)
    logits = jnp.einsum('bnqkgd,bnlkd->bkgnql', qb, kband).astype(jnp.float32) * (dh ** -0.5)
    qi = jnp.arange(WINDOW, dtype=jnp.int32)
    li = jnp.arange(2 * WINDOW, dtype=jnp.int32)
    dist = qi[:, None] + WINDOW - li[None, :]
    kpos = jnp.arange(nb, dtype=jnp.int32)[:, None] * WINDOW - WINDOW + li[None, :]
    mask = ((dist >= 0) & (dist < WINDOW))[None] & (kpos >= 0)[:, None, :]
    sl = slopes.reshape(hkv, g)[None, :, :, None, None, None]
    logits = logits - sl * dist.astype(jnp.float32)
    logits = jnp.where(mask, logits, -jnp.inf)
    sink = sinks.astype(jnp.float32).reshape(hkv, g)[None, :, :, None, None, None]
    m = jnp.maximum(jnp.max(logits, axis=-1, keepdims=True), sink)
    e = jnp.exp(logits - m)
    p = e / (jnp.sum(e, axis=-1, keepdims=True) + jnp.exp(sink - m))
    out = jnp.einsum('bkgnql,bnlkd->bnqkgd', p.astype(vband.dtype), vband)
    return out.reshape(b, s, hq * dh)


def memory_attention(qm, mem_k, mem_v):
    b, s, hm, dh = qm.shape
    logits = jnp.einsum('bshd,bmhd->bhsm', qm, mem_k).astype(jnp.float32) * (dh ** -0.5)
    p = jax.nn.softmax(logits, axis=-1).astype(mem_v.dtype)
    return jnp.einsum('bhsm,bmhd->bshd', p, mem_v).reshape(b, s, hm * dh)


def setup_inputs(seed: int = 0) -> dict:
    key = jax.random.key(seed)
    ks = jax.random.split(key, 10)
    f32 = jnp.float32
    x = jax.random.normal(ks[0], (BATCH, SEQ, D_MODEL), f32)
    mem = jax.random.normal(ks[1], (BATCH, MEM_LEN, D_MODEL), f32)
    norm_g = 1.0 + 0.05 * jax.random.normal(ks[2], (DEPTH, D_MODEL), f32)
    w_in_a = jax.random.normal(ks[3], (N_LAYERS_A, D_MODEL, IN_WIDTH_A), f32) * (D_MODEL ** -0.5)
    w_in_b = jax.random.normal(ks[4], (N_LAYERS_B, D_MODEL, IN_WIDTH_B), f32) * (D_MODEL ** -0.5)
    sinks_b = 0.5 * jax.random.normal(ks[5], (N_LAYERS_B, N_HEADS), f32)
    w_mem_kv = jax.random.normal(ks[6], (DEPTH, D_MODEL, 2 * MEM_WIDTH), f32) * (D_MODEL ** -0.5)
    w_out = jax.random.normal(ks[7], (DEPTH, BRANCH_WIDTH, D_MODEL), f32) * (BRANCH_WIDTH ** -0.5)
    mem_norm_g = 1.0 + 0.05 * jax.random.normal(ks[8], (D_MODEL,), f32)
    final_norm_g = 1.0 + 0.05 * jax.random.normal(ks[9], (D_MODEL,), f32)
    return {"x": x, "mem": mem, "norm_g": norm_g, "w_in_a": w_in_a, "w_in_b": w_in_b,
            "sinks_b": sinks_b, "w_mem_kv": w_mem_kv, "w_out": w_out,
            "mem_norm_g": mem_norm_g, "final_norm_g": final_norm_g}


def reference(x, mem, norm_g, w_in_a, w_in_b, sinks_b, w_mem_kv, w_out, mem_norm_g, final_norm_g):
    b, s, _ = x.shape
    slopes = alibi_slopes(N_HEADS)
    mem_n = rms_norm(mem, mem_norm_g)
    m_len = mem.shape[1]
    for i in range(DEPTH):
        h = rms_norm(x, norm_g[i])
        kvm = mem_n @ w_mem_kv[i]
        mem_k = kvm[..., :MEM_WIDTH].reshape(b, m_len, N_MEM_HEADS, HEAD_DIM)
        mem_v = kvm[..., MEM_WIDTH:].reshape(b, m_len, N_MEM_HEADS, HEAD_DIM)
        if i % N_MIXERS == 0:
            proj = h @ w_in_a[i // N_MIXERS]
            q, k, v, qm, z = jnp.split(
                proj, [ATTN_WIDTH, 2 * ATTN_WIDTH, 3 * ATTN_WIDTH, 3 * ATTN_WIDTH + MEM_WIDTH], axis=-1)
            y_self = moba_attention(q.reshape(b, s, N_HEADS, HEAD_DIM),
                                    k.reshape(b, s, N_HEADS, HEAD_DIM),
                                    v.reshape(b, s, N_HEADS, HEAD_DIM), slopes)
        else:
            proj = h @ w_in_b[i // N_MIXERS]
            q, k, v, qm, z = jnp.split(
                proj, [ATTN_WIDTH, ATTN_WIDTH + KV_WIDTH_B, ATTN_WIDTH + 2 * KV_WIDTH_B,
                       ATTN_WIDTH + 2 * KV_WIDTH_B + MEM_WIDTH], axis=-1)
            y_self = swa_sink_attention(q.reshape(b, s, N_HEADS, HEAD_DIM),
                                        k.reshape(b, s, N_KV_HEADS_B, HEAD_DIM),
                                        v.reshape(b, s, N_KV_HEADS_B, HEAD_DIM),
                                        sinks_b[i // N_MIXERS], slopes)
        y_mem = memory_attention(qm.reshape(b, s, N_MEM_HEADS, HEAD_DIM), mem_k, mem_v)
        y = jnp.concatenate([y_self, y_mem], axis=-1) * jax.nn.silu(z)
        x = x + y @ w_out[i]
    return rms_norm(x, final_norm_g)
```

```cpp
#include <hip/hip_runtime.h>
#include <cstdio>
#include <cstdint>
#include <cmath>

typedef _Float16 half_t;
typedef _Float16 half8 __attribute__((ext_vector_type(8)));
typedef float f32x4 __attribute__((ext_vector_type(4)));

constexpr int NB = 2, S = 16384, D = 1024, M = NB * S;
constexpr int NH = 12, HD = 64, NKVB = 2, NMH = 4, MEML = 256;
constexpr int AW = 768, MW = 256, BW = 1024;
constexpr int INA = 3584, INB = 2304;
constexpr int NBLK = S / 256;
constexpr float EPS = 1e-6f;
constexpr int A_Q = 0, A_K = 768, A_V = 1536, A_QM = 2304, A_Z = 2560;
constexpr int B_Q = 0, B_K = 768, B_V = 896, B_QM = 1024, B_Z = 1280;

__device__ __forceinline__ float slope_of(int h) {
    return h < 8 ? exp2f(-(float)(h + 1)) : exp2f(-0.5f - (float)(h - 8));
}
__device__ __forceinline__ float wave_sum(float v) {
#pragma unroll
    for (int o = 1; o < 64; o <<= 1) v += __shfl_xor(v, o);
    return v;
}
__device__ __forceinline__ float wave_max(float v) {
#pragma unroll
    for (int o = 1; o < 64; o <<= 1) v = fmaxf(v, __shfl_xor(v, o));
    return v;
}
__device__ __forceinline__ float silu(float z) { return z / (1.f + __expf(-z)); }

template <bool F16OUT>
__global__ __launch_bounds__(256) void k_rmsnorm(const float* __restrict__ x, const float* __restrict__ g, void* outp, int rows) {
    const int lane = threadIdx.x & 63, w = threadIdx.x >> 6;
    const int row = blockIdx.x * 4 + w;
    if (row >= rows) return;
    const f32x4* xr = (const f32x4*)(x + (size_t)row * D);
    f32x4 v[4]; float s = 0.f;
#pragma unroll
    for (int j = 0; j < 4; ++j) { v[j] = xr[lane + 64 * j]; s += v[j].x * v[j].x + v[j].y * v[j].y + v[j].z * v[j].z + v[j].w * v[j].w; }
    s = wave_sum(s);
    const float rstd = rsqrtf(s * (1.f / D) + EPS);
#pragma unroll
    for (int j = 0; j < 4; ++j) {
        const f32x4 gv = ((const f32x4*)g)[lane + 64 * j];
        f32x4 o = v[j] * rstd * gv;
        if (F16OUT) {
            half_t* op = (half_t*)outp + (size_t)row * D + (lane + 64 * j) * 4;
            op[0] = (half_t)o.x; op[1] = (half_t)o.y; op[2] = (half_t)o.z; op[3] = (half_t)o.w;
        } else {
            ((f32x4*)((float*)outp + (size_t)row * D))[lane + 64 * j] = o;
        }
    }
}

__global__ __launch_bounds__(256) void k_gemm_naive(const half_t* __restrict__ A, const float* __restrict__ Bw, int N, int K,
                                                     half_t* Ch, float* Cf, const float* base, int ldc) {
    __shared__ __attribute__((aligned(16))) half_t sA[64][40];
    __shared__ __attribute__((aligned(16))) half_t sB[32][72];
    const int bx = blockIdx.x * 64, by = blockIdx.y * 64;
    const int tid = threadIdx.x, lane = tid & 63, w = tid >> 6, row = lane & 15, quad = lane >> 4;
    f32x4 acc[4];
#pragma unroll
    for (int i = 0; i < 4; ++i) acc[i] = (f32x4){0.f, 0.f, 0.f, 0.f};
    for (int k0 = 0; k0 < K; k0 += 32) {
        { const int r = tid >> 2, c = (tid & 3) * 8;
          *(uint4*)&sA[r][c] = *(const uint4*)&A[(size_t)(by + r) * K + k0 + c]; }
        { const int kk = tid >> 3, c = (tid & 7) * 8;
          const float* bp = Bw + (size_t)(k0 + kk) * N + bx + c;
          const f32x4 b0 = *(const f32x4*)bp, b1 = *(const f32x4*)(bp + 4);
          half8 hv; hv[0] = (half_t)b0.x; hv[1] = (half_t)b0.y; hv[2] = (half_t)b0.z; hv[3] = (half_t)b0.w;
          hv[4] = (half_t)b1.x; hv[5] = (half_t)b1.y; hv[6] = (half_t)b1.z; hv[7] = (half_t)b1.w;
          *(half8*)&sB[kk][c] = hv; }
        __syncthreads();
        half8 a;
#pragma unroll
        for (int j = 0; j < 8; ++j) a[j] = sA[16 * w + row][quad * 8 + j];
#pragma unroll
        for (int nt = 0; nt < 4; ++nt) {
            half8 b;
#pragma unroll
            for (int j = 0; j < 8; ++j) b[j] = sB[quad * 8 + j][nt * 16 + row];
            acc[nt] = __builtin_amdgcn_mfma_f32_16x16x32_f16(a, b, acc[nt], 0, 0, 0);
        }
        __syncthreads();
    }
#pragma unroll
    for (int nt = 0; nt < 4; ++nt)
#pragma unroll
        for (int j = 0; j < 4; ++j) {
            const size_t r = by + 16 * w + quad * 4 + j, c = bx + nt * 16 + row;
            if (Ch) Ch[r * ldc + c] = (half_t)acc[nt][j];
            else Cf[r * ldc + c] = base[r * ldc + c] + acc[nt][j];
        }
}

__global__ __launch_bounds__(64) void k_kmean(const half_t* __restrict__ proj, float* __restrict__ kmean) {
    const int lane = threadIdx.x; const int n = blockIdx.x % NBLK, h = (blockIdx.x / NBLK) % NH, b = blockIdx.x / (NBLK * NH);
    const half_t* kp = proj + ((size_t)b * S + 256 * n) * INA + A_K + h * 64 + lane;
    float s = 0.f;
    for (int r = 0; r < 256; ++r) s += (float)kp[(size_t)r * INA];
    kmean[(((size_t)b * NH + h) * NBLK + n) * 64 + lane] = s * (1.f / 256.f);
}

__device__ __forceinline__ float dot64(const float (&q)[64], const half_t* kp) {
    float a = 0.f;
#pragma unroll
    for (int i = 0; i < 8; ++i) { const half8 kv = *(const half8*)(kp + 8 * i);
#pragma unroll
        for (int e = 0; e < 8; ++e) a += q[8 * i + e] * (float)kv[e]; }
    return a;
}
__device__ __forceinline__ float pv64(float p, const half_t* vp, size_t pitch, int lane, float o) {
    for (int k = 0; k < 64; ++k) { const float pk = __shfl(p, k); o += pk * (float)vp[(size_t)k * pitch + lane]; }
    return o;
}

__global__ __launch_bounds__(256) void k_moba_naive(const half_t* __restrict__ proj, const float* __restrict__ kmean, half_t* __restrict__ Y) {
    const int lane = threadIdx.x & 63, w = threadIdx.x >> 6;
    const size_t gid = (size_t)blockIdx.x * 4 + w;
    const int t = (int)(gid % S), h = (int)((gid / S) % NH), b = (int)(gid / ((size_t)S * NH));
    const size_t row = (size_t)b * S + t;
    const half_t* qp = proj + row * INA + A_Q + h * 64;
    float q[64];
#pragma unroll
    for (int i = 0; i < 8; ++i) { const half8 v = *(const half8*)(qp + 8 * i);
#pragma unroll
        for (int e = 0; e < 8; ++e) q[8 * i + e] = (float)v[e]; }
    const int j = t >> 8;
    float g = -INFINITY;
    if (lane < j) { const float* km = kmean + (((size_t)b * NH + h) * NBLK + lane) * 64; float a = 0.f;
#pragma unroll
        for (int d = 0; d < 64; ++d) a += q[d] * km[d];
        g = a; }
    int bl[4];
#pragma unroll
    for (int k = 0; k < 3; ++k) {
        float v = g; int i = lane;
#pragma unroll
        for (int o = 1; o < 64; o <<= 1) { const float ov = __shfl_xor(v, o); const int oi = __shfl_xor(i, o); if (ov > v || (ov == v && oi < i)) { v = ov; i = oi; } }
        bl[k] = (v == -INFINITY) ? -1 : i;
        if (lane == i) g = -INFINITY;
    }
    bl[3] = j;
    const float scale = 0.125f, slope = slope_of(h);
    const half_t* kbase = proj + (size_t)b * S * INA + A_K + h * 64;
    const half_t* vbase = proj + (size_t)b * S * INA + A_V + h * 64;
    float sc[16];
#pragma unroll
    for (int kb = 0; kb < 4; ++kb)
#pragma unroll
        for (int c = 0; c < 4; ++c) {
            float s = -INFINITY;
            if (bl[kb] >= 0) { const int key = bl[kb] * 256 + c * 64 + lane;
                if (key <= t) s = scale * dot64(q, kbase + (size_t)key * INA) - slope * (float)(t - key); }
            sc[kb * 4 + c] = s;
        }
    float m = sc[0];
#pragma unroll
    for (int i = 1; i < 16; ++i) m = fmaxf(m, sc[i]);
    m = wave_max(m);
    float l = 0.f;
#pragma unroll
    for (int i = 0; i < 16; ++i) { sc[i] = __expf(sc[i] - m); l += sc[i]; }
    l = wave_sum(l);
    float o = 0.f;
#pragma unroll
    for (int kb = 0; kb < 4; ++kb)
#pragma unroll
        for (int c = 0; c < 4; ++c)
            if (bl[kb] >= 0) o = pv64(sc[kb * 4 + c], vbase + (size_t)(bl[kb] * 256 + c * 64) * INA, INA, lane, o);
    const float z = (float)proj[row * INA + A_Z + h * 64 + lane];
    Y[row * BW + h * 64 + lane] = (half_t)(o / l * silu(z));
}

__global__ __launch_bounds__(256) void k_swa_naive(const half_t* __restrict__ proj, const float* __restrict__ sinks, half_t* __restrict__ Y) {
    const int lane = threadIdx.x & 63, w = threadIdx.x >> 6;
    const size_t gid = (size_t)blockIdx.x * 4 + w;
    const int t = (int)(gid % S), h = (int)((gid / S) % NH), b = (int)(gid / ((size_t)S * NH));
    const size_t row = (size_t)b * S + t;
    const int kvh = h / (NH / NKVB);
    const half_t* qp = proj + row * INB + B_Q + h * 64;
    float q[64];
#pragma unroll
    for (int i = 0; i < 8; ++i) { const half8 v = *(const half8*)(qp + 8 * i);
#pragma unroll
        for (int e = 0; e < 8; ++e) q[8 * i + e] = (float)v[e]; }
    const float scale = 0.125f, slope = slope_of(h), sink = sinks[h];
    const half_t* kbase = proj + (size_t)b * S * INB + B_K + kvh * 64;
    const half_t* vbase = proj + (size_t)b * S * INB + B_V + kvh * 64;
    float sc[2];
#pragma unroll
    for (int c = 0; c < 2; ++c) { const int key = t - 127 + c * 64 + lane; float s = -INFINITY;
        if (key >= 0) s = scale * dot64(q, kbase + (size_t)key * INB) - slope * (float)(t - key);
        sc[c] = s; }
    float m = wave_max(fmaxf(sc[0], sc[1])); m = fmaxf(m, sink);
    float l = 0.f;
#pragma unroll
    for (int c = 0; c < 2; ++c) { sc[c] = __expf(sc[c] - m); l += sc[c]; }
    l = wave_sum(l) + __expf(sink - m);
    float o = 0.f;
#pragma unroll
    for (int c = 0; c < 2; ++c) { const int k0 = t - 127 + c * 64;
        for (int k = 0; k < 64; ++k) { const float pk = __shfl(sc[c], k); const int key = k0 + k < 0 ? 0 : k0 + k; o += pk * (float)vbase[(size_t)key * INB + lane]; } }
    const float z = (float)proj[row * INB + B_Z + h * 64 + lane];
    Y[row * BW + h * 64 + lane] = (half_t)(o / l * silu(z));
}

__global__ __launch_bounds__(256) void k_mem_naive(const half_t* __restrict__ proj, int pitch, int qm_off, int z_off, const half_t* __restrict__ kvm, half_t* __restrict__ Y) {
    const int lane = threadIdx.x & 63, w = threadIdx.x >> 6;
    const size_t gid = (size_t)blockIdx.x * 4 + w;
    const int t = (int)(gid % S), h = (int)((gid / S) % NMH), b = (int)(gid / ((size_t)S * NMH));
    const size_t row = (size_t)b * S + t;
    const half_t* qp = proj + row * pitch + qm_off + h * 64;
    float q[64];
#pragma unroll
    for (int i = 0; i < 8; ++i) { const half8 v = *(const half8*)(qp + 8 * i);
#pragma unroll
        for (int e = 0; e < 8; ++e) q[8 * i + e] = (float)v[e]; }
    const half_t* kbase = kvm + (size_t)b * MEML * 512 + h * 64;
    const half_t* vbase = kbase + 256;
    float sc[4];
#pragma unroll
    for (int c = 0; c < 4; ++c) sc[c] = 0.125f * dot64(q, kbase + (size_t)(c * 64 + lane) * 512);
    float m = wave_max(fmaxf(fmaxf(sc[0], sc[1]), fmaxf(sc[2], sc[3])));
    float l = 0.f;
#pragma unroll
    for (int c = 0; c < 4; ++c) { sc[c] = __expf(sc[c] - m); l += sc[c]; }
    l = wave_sum(l);
    float o = 0.f;
#pragma unroll
    for (int c = 0; c < 4; ++c) o = pv64(sc[c], vbase + (size_t)(c * 64) * 512, 512, lane, o);
    const float z = (float)proj[row * pitch + z_off + AW + h * 64 + lane];
    Y[row * BW + AW + h * 64 + lane] = (half_t)(o / l * silu(z));
}

constexpr size_t MiB = 1u << 20;
constexpr size_t WS_H = 16 * MiB, WS_PROJ = 80 * MiB, WS_Y = 304 * MiB, WS_MEMN = 368 * MiB, WS_KVM = 369 * MiB, WS_KMEAN = 370 * MiB, WS_X2 = 372 * MiB;

extern "C" void kernel_launch(void* const* d_in, const int* in_sizes, int n_in, void* d_out, int out_size, void* d_ws, size_t ws_size, hipStream_t stream) {
    const float* x = (const float*)d_in[0]; const float* mem = (const float*)d_in[1]; const float* norm_g = (const float*)d_in[2];
    const float* w_in_a = (const float*)d_in[3]; const float* w_in_b = (const float*)d_in[4]; const float* sinks_b = (const float*)d_in[5];
    const float* w_mem_kv = (const float*)d_in[6]; const float* w_out = (const float*)d_in[7]; const float* mem_norm_g = (const float*)d_in[8];
    const float* final_norm_g = (const float*)d_in[9];
    char* ws = (char*)d_ws; float* out = (float*)d_out;
    half_t* H = (half_t*)(ws + WS_H); half_t* PROJ = (half_t*)(ws + WS_PROJ); half_t* Y = (half_t*)(ws + WS_Y);
    half_t* MEMN = (half_t*)(ws + WS_MEMN); half_t* KVM = (half_t*)(ws + WS_KVM); float* KMEAN = (float*)(ws + WS_KMEAN);
    float* X2 = (float*)(ws + WS_X2);
    if (ws_size < WS_X2 + (size_t)M * D * 4) { fprintf(stderr, "workspace too small: %zu\n", ws_size); return; }

    k_rmsnorm<true><<<NB * MEML / 4, 256, 0, stream>>>(mem, mem_norm_g, MEMN, NB * MEML);
    for (int i = 0; i < 2; ++i)
        k_gemm_naive<<<dim3(512 / 64, NB * MEML / 64), 256, 0, stream>>>(MEMN, w_mem_kv + (size_t)i * D * 512, 512, D, KVM + (size_t)i * NB * MEML * 512, nullptr, nullptr, 512);
    k_rmsnorm<true><<<M / 4, 256, 0, stream>>>(x, norm_g, H, M);
    k_gemm_naive<<<dim3(INA / 64, M / 64), 256, 0, stream>>>(H, w_in_a, INA, D, PROJ, nullptr, nullptr, INA);
    k_kmean<<<NB * NH * NBLK, 64, 0, stream>>>(PROJ, KMEAN);
    k_moba_naive<<<(unsigned)((size_t)NB * NH * S / 4), 256, 0, stream>>>(PROJ, KMEAN, Y);
    k_mem_naive<<<(unsigned)((size_t)NB * NMH * S / 4), 256, 0, stream>>>(PROJ, INA, A_QM, A_Z, KVM, Y);
    k_gemm_naive<<<dim3(D / 64, M / 64), 256, 0, stream>>>(Y, w_out, D, D, nullptr, out, x, D);
    k_rmsnorm<true><<<M / 4, 256, 0, stream>>>(out, norm_g + D, H, M);
    k_gemm_naive<<<dim3(INB / 64, M / 64), 256, 0, stream>>>(H, w_in_b, INB, D, PROJ, nullptr, nullptr, INB);
    k_swa_naive<<<(unsigned)((size_t)NB * NH * S / 4), 256, 0, stream>>>(PROJ, sinks_b, Y);
    k_mem_naive<<<(unsigned)((size_t)NB * NMH * S / 4), 256, 0, stream>>>(PROJ, INB, B_QM, B_Z, KVM + (size_t)NB * MEML * 512, Y);
    k_gemm_naive<<<dim3(D / 64, M / 64), 256, 0, stream>>>(Y, w_out + (size_t)D * D, D, D, nullptr, X2, out, D);
    k_rmsnorm<false><<<M / 4, 256, 0, stream>>>(X2, final_norm_g, out, M);
}
```

```cpp
#include <hip/hip_runtime.h>
#include <cstdio>
#include <cstdint>
#include <cmath>

typedef _Float16 half_t;
typedef _Float16 half8 __attribute__((ext_vector_type(8)));
typedef float f32x4 __attribute__((ext_vector_type(4)));

constexpr int NB = 2, S = 16384, D = 1024, M = NB * S;
constexpr int NH = 12, HD = 64, NKVB = 2, NMH = 4, MEML = 256;
constexpr int AW = 768, MW = 256, BW = 1024;
constexpr int INA = 3584, INB = 2304;
constexpr int NBLK = S / 256;
constexpr float EPS = 1e-6f;
constexpr float C2 = 0.125f * 1.4426950408889634f;
constexpr float LN2 = 0.6931471805599453f;
constexpr int A_Q = 0, A_K = 768, A_V = 1536, A_QM = 2304, A_Z = 2560;
constexpr int B_Q = 0, B_K = 768, B_V = 896, B_QM = 1024, B_Z = 1280;
constexpr size_t PO_SLOT = (size_t)NB * NH * S * 64, PML_SLOT = (size_t)NB * NH * S * 2;
constexpr int KVP = 1024;

__device__ __forceinline__ float slope_of(int h) {
    return h < 8 ? exp2f(-(float)(h + 1)) : exp2f(-0.5f - (float)(h - 8));
}
__device__ __forceinline__ float wave_sum(float v) {
#pragma unroll
    for (int o = 1; o < 64; o <<= 1) v += __shfl_xor(v, o);
    return v;
}
__device__ __forceinline__ float wave_max(float v) {
#pragma unroll
    for (int o = 1; o < 64; o <<= 1) v = fmaxf(v, __shfl_xor(v, o));
    return v;
}
__device__ __forceinline__ float silu(float z) { return z / (1.f + __expf(-z)); }

template <bool F16OUT>
__global__ __launch_bounds__(256) void k_rmsnorm(const float* __restrict__ x, const float* __restrict__ g, void* outp, int rows) {
    const int lane = threadIdx.x & 63, w = threadIdx.x >> 6;
    const int row = blockIdx.x * 4 + w;
    if (row >= rows) return;
    const f32x4* xr = (const f32x4*)(x + (size_t)row * D);
    f32x4 v[4]; float s = 0.f;
#pragma unroll
    for (int j = 0; j < 4; ++j) { v[j] = xr[lane + 64 * j]; s += v[j].x * v[j].x + v[j].y * v[j].y + v[j].z * v[j].z + v[j].w * v[j].w; }
    s = wave_sum(s);
    const float rstd = rsqrtf(s * (1.f / D) + EPS);
#pragma unroll
    for (int j = 0; j < 4; ++j) {
        const f32x4 gv = ((const f32x4*)g)[lane + 64 * j];
        f32x4 o = v[j] * rstd * gv;
        if (F16OUT) {
            half_t* op = (half_t*)outp + (size_t)row * D + (lane + 64 * j) * 4;
            op[0] = (half_t)o.x; op[1] = (half_t)o.y; op[2] = (half_t)o.z; op[3] = (half_t)o.w;
        } else {
            ((f32x4*)((float*)outp + (size_t)row * D))[lane + 64 * j] = o;
        }
    }
}

__global__ __launch_bounds__(256) void k_gemm_naive(const half_t* __restrict__ A, const float* __restrict__ Bw, int N, int K,
                                                     half_t* Ch, float* Cf, const float* base, int ldc) {
    __shared__ __attribute__((aligned(16))) half_t sA[64][40];
    __shared__ __attribute__((aligned(16))) half_t sB[32][72];
    const int bx = blockIdx.x * 64, by = blockIdx.y * 64;
    const int tid = threadIdx.x, lane = tid & 63, w = tid >> 6, row = lane & 15, quad = lane >> 4;
    f32x4 acc[4];
#pragma unroll
    for (int i = 0; i < 4; ++i) acc[i] = (f32x4){0.f, 0.f, 0.f, 0.f};
    for (int k0 = 0; k0 < K; k0 += 32) {
        { const int r = tid >> 2, c = (tid & 3) * 8;
          *(uint4*)&sA[r][c] = *(const uint4*)&A[(size_t)(by + r) * K + k0 + c]; }
        { const int kk = tid >> 3, c = (tid & 7) * 8;
          const float* bp = Bw + (size_t)(k0 + kk) * N + bx + c;
          const f32x4 b0 = *(const f32x4*)bp, b1 = *(const f32x4*)(bp + 4);
          half8 hv; hv[0] = (half_t)b0.x; hv[1] = (half_t)b0.y; hv[2] = (half_t)b0.z; hv[3] = (half_t)b0.w;
          hv[4] = (half_t)b1.x; hv[5] = (half_t)b1.y; hv[6] = (half_t)b1.z; hv[7] = (half_t)b1.w;
          *(half8*)&sB[kk][c] = hv; }
        __syncthreads();
        half8 a;
#pragma unroll
        for (int j = 0; j < 8; ++j) a[j] = sA[16 * w + row][quad * 8 + j];
#pragma unroll
        for (int nt = 0; nt < 4; ++nt) {
            half8 b;
#pragma unroll
            for (int j = 0; j < 8; ++j) b[j] = sB[quad * 8 + j][nt * 16 + row];
            acc[nt] = __builtin_amdgcn_mfma_f32_16x16x32_f16(a, b, acc[nt], 0, 0, 0);
        }
        __syncthreads();
    }
#pragma unroll
    for (int nt = 0; nt < 4; ++nt)
#pragma unroll
        for (int j = 0; j < 4; ++j) {
            const size_t r = by + 16 * w + quad * 4 + j, c = bx + nt * 16 + row;
            if (Ch) Ch[r * ldc + c] = (half_t)acc[nt][j];
            else Cf[r * ldc + c] = base[r * ldc + c] + acc[nt][j];
        }
}

__device__ __forceinline__ float dot64(const float (&q)[64], const half_t* kp) {
    float a = 0.f;
#pragma unroll
    for (int i = 0; i < 8; ++i) { const half8 kv = *(const half8*)(kp + 8 * i);
#pragma unroll
        for (int e = 0; e < 8; ++e) a += q[8 * i + e] * (float)kv[e]; }
    return a;
}
__device__ __forceinline__ float pv64(float p, const half_t* vp, size_t pitch, int lane, float o) {
    for (int k = 0; k < 64; ++k) { const float pk = __shfl(p, k); o += pk * (float)vp[(size_t)k * pitch + lane]; }
    return o;
}

__global__ __launch_bounds__(256) void k_moba_naive(const half_t* __restrict__ proj, const float* __restrict__ ksum, half_t* __restrict__ Y) {
    const int lane = threadIdx.x & 63, w = threadIdx.x >> 6;
    const size_t gid = (size_t)blockIdx.x * 4 + w;
    const int t = (int)(gid % S), h = (int)((gid / S) % NH), b = (int)(gid / ((size_t)S * NH));
    const size_t row = (size_t)b * S + t;
    const half_t* qp = proj + row * INA + A_Q + h * 64;
    float q[64];
#pragma unroll
    for (int i = 0; i < 8; ++i) { const half8 v = *(const half8*)(qp + 8 * i);
#pragma unroll
        for (int e = 0; e < 8; ++e) q[8 * i + e] = (float)v[e]; }
    const int j = t >> 8;
    float g = -INFINITY;
    if (lane < j) { const float* km = ksum + ((size_t)b * NBLK + lane) * AW + h * 64; float a = 0.f;
#pragma unroll
        for (int d = 0; d < 64; ++d) a += q[d] * km[d];
        g = a; }
    int bl[4];
#pragma unroll
    for (int k = 0; k < 3; ++k) {
        float v = g; int i = lane;
#pragma unroll
        for (int o = 1; o < 64; o <<= 1) { const float ov = __shfl_xor(v, o); const int oi = __shfl_xor(i, o); if (ov > v || (ov == v && oi < i)) { v = ov; i = oi; } }
        bl[k] = (v == -INFINITY) ? -1 : i;
        if (lane == i) g = -INFINITY;
    }
    bl[3] = j;
    const float slope = slope_of(h);
    const half_t* kbase = proj + (size_t)b * S * INA + A_K + h * 64;
    const half_t* vbase = proj + (size_t)b * S * INA + A_V + h * 64;
    float sc[16];
#pragma unroll
    for (int kb = 0; kb < 4; ++kb)
#pragma unroll
        for (int c = 0; c < 4; ++c) {
            float s = -INFINITY;
            if (bl[kb] >= 0) { const int key = bl[kb] * 256 + c * 64 + lane;
                if (key <= t) s = LN2 * dot64(q, kbase + (size_t)key * INA) - slope * (float)(t - key); }
            sc[kb * 4 + c] = s;
        }
    float m = sc[0];
#pragma unroll
    for (int i = 1; i < 16; ++i) m = fmaxf(m, sc[i]);
    m = wave_max(m);
    float l = 0.f;
#pragma unroll
    for (int i = 0; i < 16; ++i) { sc[i] = __expf(sc[i] - m); l += sc[i]; }
    l = wave_sum(l);
    float o = 0.f;
#pragma unroll
    for (int kb = 0; kb < 4; ++kb)
#pragma unroll
        for (int c = 0; c < 4; ++c)
            if (bl[kb] >= 0) o = pv64(sc[kb * 4 + c], vbase + (size_t)(bl[kb] * 256 + c * 64) * INA, INA, lane, o);
    const float z = (float)proj[row * INA + A_Z + h * 64 + lane];
    Y[row * BW + h * 64 + lane] = (half_t)(o / l * silu(z));
}

__global__ __launch_bounds__(256) void k_swa_naive(const half_t* __restrict__ proj, const float* __restrict__ sinks, half_t* __restrict__ Y) {
    const int lane = threadIdx.x & 63, w = threadIdx.x >> 6;
    const size_t gid = (size_t)blockIdx.x * 4 + w;
    const int t = (int)(gid % S), h = (int)((gid / S) % NH), b = (int)(gid / ((size_t)S * NH));
    const size_t row = (size_t)b * S + t;
    const int kvh = h / (NH / NKVB);
    const half_t* qp = proj + row * INB + B_Q + h * 64;
    float q[64];
#pragma unroll
    for (int i = 0; i < 8; ++i) { const half8 v = *(const half8*)(qp + 8 * i);
#pragma unroll
        for (int e = 0; e < 8; ++e) q[8 * i + e] = (float)v[e]; }
    const float slope = slope_of(h), sink = sinks[h];
    const half_t* kbase = proj + (size_t)b * S * INB + B_K + kvh * 64;
    const half_t* vbase = proj + (size_t)b * S * INB + B_V + kvh * 64;
    float sc[2];
#pragma unroll
    for (int c = 0; c < 2; ++c) { const int key = t - 127 + c * 64 + lane; float s = -INFINITY;
        if (key >= 0) s = LN2 * dot64(q, kbase + (size_t)key * INB) - slope * (float)(t - key);
        sc[c] = s; }
    float m = wave_max(fmaxf(sc[0], sc[1])); m = fmaxf(m, sink);
    float l = 0.f;
#pragma unroll
    for (int c = 0; c < 2; ++c) { sc[c] = __expf(sc[c] - m); l += sc[c]; }
    l = wave_sum(l) + __expf(sink - m);
    float o = 0.f;
#pragma unroll
    for (int c = 0; c < 2; ++c) { const int k0 = t - 127 + c * 64;
        for (int k = 0; k < 64; ++k) { const float pk = __shfl(sc[c], k); const int key = k0 + k < 0 ? 0 : k0 + k; o += pk * (float)vbase[(size_t)key * INB + lane]; } }
    const float z = (float)proj[row * INB + B_Z + h * 64 + lane];
    Y[row * BW + h * 64 + lane] = (half_t)(o / l * silu(z));
}

__global__ __launch_bounds__(256) void k_mem_naive(const half_t* __restrict__ proj, int pitch, int qm_off, int z_off, const half_t* __restrict__ kvm, half_t* __restrict__ Y) {
    const int lane = threadIdx.x & 63, w = threadIdx.x >> 6;
    const size_t gid = (size_t)blockIdx.x * 4 + w;
    const int t = (int)(gid % S), h = (int)((gid / S) % NMH), b = (int)(gid / ((size_t)S * NMH));
    const size_t row = (size_t)b * S + t;
    const half_t* qp = proj + row * pitch + qm_off + h * 64;
    float q[64];
#pragma unroll
    for (int i = 0; i < 8; ++i) { const half8 v = *(const half8*)(qp + 8 * i);
#pragma unroll
        for (int e = 0; e < 8; ++e) q[8 * i + e] = (float)v[e]; }
    const half_t* kbase = kvm + (size_t)b * MEML * KVP + h * 64;
    const half_t* vbase = kbase + 256;
    float sc[4];
#pragma unroll
    for (int c = 0; c < 4; ++c) sc[c] = LN2 * dot64(q, kbase + (size_t)(c * 64 + lane) * KVP);
    float m = wave_max(fmaxf(fmaxf(sc[0], sc[1]), fmaxf(sc[2], sc[3])));
    float l = 0.f;
#pragma unroll
    for (int c = 0; c < 4; ++c) { sc[c] = __expf(sc[c] - m); l += sc[c]; }
    l = wave_sum(l);
    float o = 0.f;
#pragma unroll
    for (int c = 0; c < 4; ++c) o = pv64(sc[c], vbase + (size_t)(c * 64) * KVP, KVP, lane, o);
    const float z = (float)proj[row * pitch + z_off + AW + h * 64 + lane];
    Y[row * BW + AW + h * 64 + lane] = (half_t)(o / l * silu(z));
}

namespace pg8 {
#define PG8_LAS __attribute__((address_space(3)))
typedef _Float16 bf16_t;
typedef _Float16 bf16x8 __attribute__((ext_vector_type(8)));
typedef float f32x4 __attribute__((ext_vector_type(4)));
typedef unsigned u32x4 __attribute__((ext_vector_type(4)));
constexpr int BM = 256, BK = 64, HALF = 128, HTB = HALF * BK * 2  , STAGE_BYTES = 8 * HTB, NXCD = 8, WGM = 8;

__host__ __device__ __forceinline__ int lds_byte(int r, int c) { const int st = (r >> 4) * 2 + (c >> 5), rr = r & 15, cc = c & 31, ob = rr * 64 + cc * 2; return st * 1024 + (ob ^ (((ob >> 9) & 1) << 5)); }
__host__ __device__ __forceinline__ void stage_rc(int b, int& R, int& C) { const int st = b / 1024, sb = b % 1024, swz = sb ^ (((sb >> 9) & 1) << 5); R = (st >> 1) * 16 + swz / 64; C = (st & 1) * 32 + (swz % 64) / 2; }
__host__ __device__ __forceinline__ int perm32(int rho) { const int n = rho >> 4, i = rho & 15; return 8 * (i >> 2) + 4 * n + (i & 3); }

struct Unit { int pm, pn; };
struct Gemm { const bf16_t* A; const bf16_t* Bt; int M, N, K; };

struct StaticOrder {
    int nM, nN, nwg, G, c;
    __host__ __device__ void init(int M, int N, int G_, int c_) { nM = M / BM; nN = N / BM; nwg = nM * nN; G = G_; c = c_; }
    __host__ __device__ bool next(int i, Unit& u) const {
        const long L = (long)i * G + c; if (L >= nwg) return false;
        int wgid = (int)L; { const int q = nwg / NXCD, r = nwg % NXCD, xcd = wgid % NXCD, off = wgid / NXCD; wgid = (xcd < r ? xcd * (q + 1) : r * (q + 1) + (xcd - r) * q) + off; }
        const int nig = WGM * nN, gid = wgid / nig, fm = gid * WGM, gsz = (nM - fm) < WGM ? (nM - fm) : WGM;
        u.pm = fm + ((wgid % nig) % gsz); u.pn = (wgid % nig) / gsz; return true;
    }
    __device__ __forceinline__ void a_ready(const Unit&) const {}
    __device__ __forceinline__ void done(const Unit&) const {}
};
typedef float f32x2 __attribute__((ext_vector_type(2)));
typedef _Float16 half2v __attribute__((ext_vector_type(2)));
__device__ __forceinline__ unsigned cvt_pk_f16(float lo, float hi) { f32x2 v = {lo, hi}; half2v h = __builtin_convertvector(v, half2v); return __builtin_bit_cast(unsigned, h); }

struct EpiF16 {
    static constexpr bool PERM = true, AFTER_DRAIN = false;
    bf16_t* O; int ldc; unsigned qmask, kmask; float* ksum; int ktile0;
    __device__ __forceinline__ void operator()(const f32x4 (&acc)[2][2][4][2], const Unit& u, int wr, int wc, int fr, int fq) const {
        const int row0 = u.pm * BM + wr * 64 + fr; const int col0 = u.pn * BM + wc * 32 + 8 * fq;
        const float sc = ((qmask >> u.pn) & 1u) ? C2 : 1.f;
#pragma unroll
        for (int ai = 0; ai < 2; ++ai)
#pragma unroll
            for (int m = 0; m < 4; ++m) { bf16_t* rowp = O + (size_t)(row0 + ai * HALF + m * 16) * ldc + col0;
#pragma unroll
                for (int bj = 0; bj < 2; ++bj) { const f32x4 v0 = acc[ai][bj][m][0] * sc, v1 = acc[ai][bj][m][1] * sc;
                    u32x4 w; w.x = cvt_pk_f16(v0[0], v0[1]); w.y = cvt_pk_f16(v0[2], v0[3]); w.z = cvt_pk_f16(v1[0], v1[1]); w.w = cvt_pk_f16(v1[2], v1[3]);
                    *(u32x4*)(rowp + bj * HALF) = w; } }
        if ((kmask >> u.pn) & 1u) {
            float* kp = ksum + (size_t)u.pm * 768 + (u.pn - ktile0) * 256 + wc * 32 + 8 * fq;
#pragma unroll
            for (int bj = 0; bj < 2; ++bj)
#pragma unroll
                for (int n = 0; n < 2; ++n) { f32x4 s = acc[0][bj][0][n];
#pragma unroll
                    for (int am = 1; am < 8; ++am) s += acc[am >> 2][bj][am & 3][n];
#pragma unroll
                    for (int e = 0; e < 4; ++e) { float v = s[e];
#pragma unroll
                        for (int o = 1; o < 16; o <<= 1) v += __shfl_xor(v, o);
                        if (fr == 0) atomicAdd(kp + bj * HALF + 4 * n + e, v); } }
        }
    }
};
struct EpiResF32 {
    static constexpr bool PERM = false, AFTER_DRAIN = false;
    const float* base; float* out; int ldc;
    __device__ __forceinline__ void operator()(const f32x4 (&acc)[2][2][4][2], const Unit& u, int wr, int wc, int fr, int fq) const {
        const int row0 = u.pm * BM + wr * 64 + fr, col0 = u.pn * BM + wc * 32 + 4 * fq;
#pragma unroll
        for (int ai = 0; ai < 2; ++ai)
#pragma unroll
            for (int m = 0; m < 4; ++m) { const size_t off = (size_t)(row0 + ai * HALF + m * 16) * ldc + col0;
#pragma unroll
                for (int bj = 0; bj < 2; ++bj)
#pragma unroll
                    for (int n = 0; n < 2; ++n) *(f32x4*)(out + off + bj * HALF + n * 16) = *(const f32x4*)(base + off + bj * HALF + n * 16) + acc[ai][bj][m][n]; }
    }
};
template <class Epi, class Sched, bool ALIGN_EPI = false, bool SP2 = false>
__device__ __forceinline__ void gemm_phase(PG8_LAS unsigned char* lds, const Gemm g, const Sched& S, const Epi& E) {
    const int tid = threadIdx.x, wid = __builtin_amdgcn_readfirstlane(tid >> 6), lane = tid & 63, wr = wid >> 2, wc = wid & 3, fr = lane & 15, fq = lane >> 4;
    const int K = g.K, nt = K / BK;
    unsigned voffA[2], voffB[2];
#pragma unroll
    for (int i = 0; i < 2; ++i) { int R, C; stage_rc(tid * 16 + i * 8192, R, C); const int Rb = Epi::PERM ? ((R & ~31) + perm32(R & 31)) : R;
        voffA[i] = (unsigned)(R * K + C) * 2u; voffB[i] = (unsigned)(Rb * K + C) * 2u; }
    const size_t kstep = (size_t)(BK * 2);
    const size_t hstep = (size_t)HALF * K * 2;
    const size_t tstep = 2 * hstep;
    const unsigned ldsw = (unsigned)wid * 1024u;
    const int aoff = lds_byte(wr * 64 + fr, fq * 8), boff = lds_byte(wc * 32 + fr, fq * 8);
#define PG8_SA(b, h) (((b) * 2 + (h)) * HTB)
#define PG8_SB(b, h) ((4 + (b) * 2 + (h)) * HTB)
#define PG8_STAGE(bufoff, gbase, voff) do { _Pragma("unroll") for (int _i = 0; _i < 2; ++_i) \
        __builtin_amdgcn_global_load_lds((const unsigned*)((const char*)(gbase) + (voff)[_i]), (PG8_LAS unsigned*)(lds + (bufoff) + ldsw + _i * 8192), 16, 0, 0); } while (0)
#define PG8_LDA(dst, b, h) do { _Pragma("unroll") for (int m = 0; m < 4; ++m) _Pragma("unroll") for (int k = 0; k < 2; ++k) dst[m][k] = *(const PG8_LAS bf16x8*)(lds + PG8_SA(b, h) + aoff + m * 2048 + k * 1024); } while (0)
#define PG8_LDB(dst, b, h) do { _Pragma("unroll") for (int n = 0; n < 2; ++n) _Pragma("unroll") for (int k = 0; k < 2; ++k) dst[n][k] = *(const PG8_LAS bf16x8*)(lds + PG8_SB(b, h) + boff + n * 2048 + k * 1024); } while (0)
#define PG8_MMA(ai, bj, At, Bt) do { __builtin_amdgcn_s_setprio(1); _Pragma("unroll") for (int m = 0; m < 4; ++m) _Pragma("unroll") for (int n = 0; n < 2; ++n) _Pragma("unroll") for (int k = 0; k < 2; ++k) \
        acc[ai][bj][m][n] = __builtin_amdgcn_mfma_f32_16x16x32_f16(Bt[n][k], At[m][k], acc[ai][bj][m][n], 0, 0, 0); __builtin_amdgcn_s_setprio(0); } while (0)
#define PG8_WAIT_V(n) asm volatile("s_waitcnt vmcnt(" #n ")" ::: "memory")
#define PG8_WAIT_L(n) asm volatile("s_waitcnt lgkmcnt(" #n ")" ::: "memory")
#define PG8_BAR __builtin_amdgcn_s_barrier()
#define PG8_SCHED __builtin_amdgcn_sched_barrier(0)
    Unit cur, nxt; int ui = 0;
    if (!S.next(0, cur)) return;
    f32x4 acc[2][2][4][2];
#pragma unroll
    for (int a = 0; a < 2; ++a)
#pragma unroll
        for (int b = 0; b < 2; ++b)
#pragma unroll
            for (int m = 0; m < 4; ++m)
#pragma unroll
                for (int n = 0; n < 2; ++n) acc[a][b][m][n] = (f32x4){0.f, 0.f, 0.f, 0.f};
    bf16x8 At[4][2], B0[2][2], B1[2][2];
    const char* cA = (const char*)g.A + (size_t)cur.pm * tstep; const char* cB = (const char*)g.Bt + (size_t)cur.pn * tstep;
    S.a_ready(cur);
    if constexpr (SP2) {
        PG8_STAGE(PG8_SB(0, 0), cB, voffB); PG8_STAGE(PG8_SB(0, 1), cB + hstep, voffB); PG8_STAGE(PG8_SA(0, 0), cA, voffA); PG8_STAGE(PG8_SA(0, 1), cA + hstep, voffA);
        if (wr == 1) PG8_BAR;
        PG8_WAIT_V(2); PG8_BAR;
        PG8_STAGE(PG8_SB(1, 0), cB + kstep, voffB); PG8_STAGE(PG8_SA(1, 0), cA + kstep, voffA); PG8_STAGE(PG8_SB(1, 1), cB + hstep + kstep, voffB);
        PG8_WAIT_V(6); PG8_BAR;
    } else {
        PG8_STAGE(PG8_SB(0, 0), cB, voffB); PG8_STAGE(PG8_SA(0, 0), cA, voffA); PG8_STAGE(PG8_SB(0, 1), cB + hstep, voffB); PG8_STAGE(PG8_SA(0, 1), cA + hstep, voffA);
        if (wr == 1) PG8_BAR;
        PG8_WAIT_V(4); PG8_BAR;
        PG8_STAGE(PG8_SB(1, 0), cB + kstep, voffB); PG8_STAGE(PG8_SA(1, 0), cA + kstep, voffA); PG8_STAGE(PG8_SB(1, 1), cB + hstep + kstep, voffB);
        PG8_WAIT_V(6); PG8_BAR;
    }
    for (;;) {
        const bool has_next = S.next(ui + 1, nxt);
        const char* nA = has_next ? (const char*)g.A + (size_t)nxt.pm * tstep : cA; const char* nB = has_next ? (const char*)g.Bt + (size_t)nxt.pn * tstep : cB;
        for (int t = 0; t < nt; t += 2) {
            const bool last = (t == nt - 2);
            const char* a1 = cA + (size_t)(t + 1) * kstep;
            const char* a2 = last ? nA : cA + (size_t)(t + 2) * kstep; const char* b2 = last ? nB : cB + (size_t)(t + 2) * kstep;
            const char* a3 = a2 + kstep; const char* b3 = b2 + kstep;
            if (last && has_next) S.a_ready(nxt);
            if constexpr (SP2) {
            PG8_LDB(B0, 0, 0); PG8_LDB(B1, 0, 1); PG8_SCHED; PG8_LDA(At, 0, 0); PG8_STAGE(PG8_SA(1, 1), a1 + hstep, voffA);
            PG8_WAIT_V(8); PG8_WAIT_L(0); PG8_BAR; PG8_MMA(0, 0, At, B0); PG8_MMA(0, 1, At, B1); PG8_BAR; PG8_SCHED;
            PG8_LDA(At, 0, 1); PG8_STAGE(PG8_SB(0, 0), b2, voffB); PG8_STAGE(PG8_SB(0, 1), b2 + hstep, voffB); PG8_STAGE(PG8_SA(0, 0), a2, voffA);
            PG8_WAIT_V(8); PG8_WAIT_L(0); PG8_BAR; PG8_MMA(1, 0, At, B0); PG8_MMA(1, 1, At, B1); PG8_BAR; PG8_SCHED;
            PG8_LDB(B0, 1, 0); PG8_LDB(B1, 1, 1); PG8_SCHED; PG8_LDA(At, 1, 0); PG8_STAGE(PG8_SA(0, 1), a2 + hstep, voffA);
            PG8_WAIT_V(8); PG8_WAIT_L(0); PG8_BAR; PG8_MMA(0, 0, At, B0); PG8_MMA(0, 1, At, B1); PG8_BAR; PG8_SCHED;
            PG8_LDA(At, 1, 1); PG8_STAGE(PG8_SB(1, 0), b3, voffB); PG8_STAGE(PG8_SB(1, 1), b3 + hstep, voffB); PG8_STAGE(PG8_SA(1, 0), a3, voffA);
            PG8_WAIT_V(8); PG8_WAIT_L(0); PG8_BAR; PG8_MMA(1, 0, At, B0); PG8_MMA(1, 1, At, B1); PG8_BAR; PG8_SCHED;
            } else {
            PG8_LDB(B0, 0, 0); PG8_SCHED; PG8_LDA(At, 0, 0); PG8_STAGE(PG8_SA(1, 1), a1 + hstep, voffA);
            PG8_WAIT_L(8); PG8_BAR; PG8_WAIT_L(0); PG8_MMA(0, 0, At, B0); PG8_BAR; PG8_SCHED;
            PG8_LDB(B1, 0, 1); PG8_STAGE(PG8_SB(0, 0), b2, voffB);
            PG8_BAR; PG8_WAIT_L(0); PG8_MMA(0, 1, At, B1); PG8_BAR;
            PG8_LDA(At, 0, 1); PG8_STAGE(PG8_SA(0, 0), a2, voffA);
            PG8_BAR; PG8_WAIT_L(0); PG8_MMA(1, 0, At, B0); PG8_BAR; PG8_SCHED;
            PG8_STAGE(PG8_SB(0, 1), b2 + hstep, voffB);
            PG8_WAIT_V(6); PG8_BAR; PG8_MMA(1, 1, At, B1); PG8_BAR;
            PG8_LDB(B0, 1, 0); PG8_SCHED; PG8_LDA(At, 1, 0); PG8_STAGE(PG8_SA(0, 1), a2 + hstep, voffA);
            PG8_WAIT_L(8); PG8_BAR; PG8_WAIT_L(0); PG8_MMA(0, 0, At, B0); PG8_BAR; PG8_SCHED;
            PG8_LDB(B1, 1, 1); PG8_STAGE(PG8_SB(1, 0), b3, voffB);
            PG8_BAR; PG8_WAIT_L(0); PG8_MMA(0, 1, At, B1); PG8_BAR;
            PG8_LDA(At, 1, 1); PG8_STAGE(PG8_SA(1, 0), a3, voffA);
            PG8_BAR; PG8_WAIT_L(0); PG8_MMA(1, 0, At, B0); PG8_BAR; PG8_SCHED;
            PG8_STAGE(PG8_SB(1, 1), b3 + hstep, voffB);
            PG8_WAIT_V(6); PG8_BAR; PG8_MMA(1, 1, At, B1); PG8_BAR;
            }
        }
        if constexpr (ALIGN_EPI) { if (wr == 0) PG8_BAR; }
        if constexpr (!Epi::AFTER_DRAIN) { E(acc, cur, wr, wc, fr, fq); S.done(cur); }
        if (!has_next) break;
#pragma unroll
        for (int a = 0; a < 2; ++a)
#pragma unroll
            for (int b = 0; b < 2; ++b)
#pragma unroll
                for (int m = 0; m < 4; ++m)
#pragma unroll
                    for (int n = 0; n < 2; ++n) acc[a][b][m][n] = (f32x4){0.f, 0.f, 0.f, 0.f};
        cur = nxt; cA = nA; cB = nB; ++ui;
        if constexpr (ALIGN_EPI) { if (wr == 1) PG8_BAR; }
    }
    PG8_WAIT_V(0);
    if constexpr (!ALIGN_EPI) { if (wr == 0) PG8_BAR; }
    PG8_BAR;
    if constexpr (Epi::AFTER_DRAIN) { E.fused(acc, cur, wr, wc, fr, fq, lds, wid, lane); S.done(cur); }
#undef PG8_SA
#undef PG8_SB
#undef PG8_STAGE
#undef PG8_LDA
#undef PG8_LDB
#undef PG8_MMA
#undef PG8_WAIT_V
#undef PG8_WAIT_L
#undef PG8_BAR
#undef PG8_SCHED
}
}

#define GAS __attribute__((address_space(1)))
#define LAS __attribute__((address_space(3)))
typedef unsigned v4u __attribute__((ext_vector_type(4)));
typedef GAS unsigned gu32;
typedef GAS unsigned long long gu64;
#define RLX_AGENT __ATOMIC_RELAXED, __HIP_MEMORY_SCOPE_AGENT
#define LDS_WAIT() asm volatile("s_waitcnt lgkmcnt(0)" ::: "memory")
#define VM_WAIT() asm volatile("s_waitcnt vmcnt(0)" ::: "memory")
__device__ __forceinline__ unsigned long long rt() { return __builtin_amdgcn_s_memrealtime(); }

#define XB_TMO      128
#define XB_XCNT(j)  (256  + 64 * (j))
#define XB_XSUB(j)  (1280 + 64 * (j))
#define XB_XGEN(j)  (2304 + 64 * (j))
#define XB_TOP      3328
#define XB_TOPGEN   3392
#define XCD_BAR_WORDS 3456
#define XB_SPIN_CAP (1u << 18)

__device__ __forceinline__ unsigned xb_ld(unsigned* p)              { return __hip_atomic_load(p, __ATOMIC_RELAXED, __HIP_MEMORY_SCOPE_AGENT); }
__device__ __forceinline__ unsigned xb_add(unsigned* p, unsigned v) { return __hip_atomic_fetch_add(p, v, __ATOMIC_RELAXED, __HIP_MEMORY_SCOPE_AGENT); }
__device__ __forceinline__ unsigned xb_xcc_id() { return (unsigned)__builtin_amdgcn_s_getreg((3 << 11) | 20) & 0xFu; }
#define XB_SPIN(cond, bar) do { unsigned _sp = 0; while (cond) { __builtin_amdgcn_s_sleep(1); \
    if ((++_sp & 255u) == 0u) { if (xb_ld(&(bar)[XB_TMO])) break; if (_sp > XB_SPIN_CAP) { atomicAdd(&(bar)[XB_TMO], 1u); break; } } } } while (0)

struct XcdBarrier {
    unsigned* bar; unsigned x;
    volatile LAS unsigned* st;
};

__device__ __forceinline__ XcdBarrier xcd_barrier_post(unsigned* bar, volatile LAS unsigned* st) {
    XcdBarrier b; b.bar = bar; b.x = xb_xcc_id(); b.st = st;
    if (threadIdx.x == 0) (void)xb_add(&bar[XB_XCNT(b.x)], 1u);
    return b;
}
__device__ __forceinline__ void xcd_barrier_complete(unsigned* bar, unsigned x, unsigned& nloc, unsigned& nx) {
    const unsigned G = gridDim.x * gridDim.y * gridDim.z;
    unsigned sum, cnt, mine, sp = 0u;
    for (;;) {
        sum = 0u; cnt = 0u; mine = 0u;
#pragma unroll
        for (unsigned j = 0; j < 16; ++j) { const unsigned c = xb_ld(&bar[XB_XCNT(j)]); sum += c; cnt += (c > 0u) ? 1u : 0u; mine = (j == x) ? c : mine; }
        if (sum == G) break;
        __builtin_amdgcn_s_sleep(1);
        if ((++sp & 255u) == 0u) { if (xb_ld(&bar[XB_TMO])) break; if (sp > XB_SPIN_CAP) { atomicAdd(&bar[XB_TMO], 1u); break; } }
    }
    nloc = mine > 0u ? mine : 1u; nx = cnt > 0u ? cnt : 1u;
}

__device__ __forceinline__ void xcd_barrier(const XcdBarrier& b) {
    asm volatile("s_waitcnt vmcnt(0)" ::: "memory");
    __syncthreads();
    if (threadIdx.x == 0) {
        unsigned* bar = b.bar;
        __builtin_amdgcn_s_waitcnt(0);
        unsigned nloc = b.st[0], nx = b.st[1];
        if (nloc == 0u) { xcd_barrier_complete(bar, b.x, nloc, nx); b.st[0] = nloc; b.st[1] = nx; }
        const unsigned old = xb_add(&bar[XB_XSUB(b.x)], 1u);
        const unsigned gen = old / nloc;
        if (old + 1u == (gen + 1u) * nloc) {
            __builtin_amdgcn_fence(__ATOMIC_RELEASE, "agent");
            asm volatile("s_waitcnt vmcnt(0)" ::: "memory");
            const unsigned og = xb_add(&bar[XB_TOP], 1u);
            const unsigned tg = og / nx;
            if (og + 1u == (tg + 1u) * nx) xb_add(&bar[XB_TOPGEN], 1u);
            else XB_SPIN(xb_ld(&bar[XB_TOPGEN]) == tg, bar);
            __builtin_amdgcn_fence(__ATOMIC_ACQUIRE, "agent");
            xb_add(&bar[XB_XGEN(b.x)], 1u);
            asm volatile("s_waitcnt vmcnt(0)" ::: "memory");
        } else {
            XB_SPIN(xb_ld(&bar[XB_XGEN(b.x)]) == gen, bar);
            __builtin_amdgcn_fence(__ATOMIC_ACQUIRE, "agent");
            asm volatile("s_waitcnt vmcnt(0)" ::: "memory");
        }
    }
    __syncthreads();
}

namespace att {
typedef _Float16 half8 __attribute__((ext_vector_type(8)));
typedef _Float16 half4 __attribute__((ext_vector_type(4)));
typedef short v4i16_t __attribute__((ext_vector_type(4)));
typedef float f32x16 __attribute__((ext_vector_type(16)));
typedef float f32x4 __attribute__((ext_vector_type(4)));
typedef unsigned u32x4 __attribute__((ext_vector_type(4)));
#define ALAS __attribute__((address_space(3)))
typedef ALAS const char* lds_cptr;
constexpr int SLOTB = 8192, NSLOT = 3;
constexpr int L_K = 0, L_V = NSLOT * SLOTB, L_WS = 2 * NSLOT * SLOTB, WS_PER_WAVE = 512, L_ST = L_WS + 8 * WS_PER_WAVE, ST_PITCH = 68, ST_PER_WAVE = 32 * ST_PITCH * 4;
constexpr int L_CUM = L_ST + 8 * ST_PER_WAVE, L_END = L_CUM + 1536 * 4 + 1024;
static_assert(L_END <= 131072, "attention LDS map");
constexpr float NEG_BIG = -1.0e30f;

__device__ __forceinline__ int crow(int r, int hi) { return (r & 3) + 8 * (r >> 2) + 4 * hi; }
__device__ __forceinline__ void glds16(const void* g, unsigned lds_base) {
    unsigned sv; asm volatile("s_mov_b32 %0, m0\n\ts_mov_b32 m0, %2\n\ts_nop 0\n\tglobal_load_lds_dwordx4 %1, off\n\ts_mov_b32 m0, %0" : "=&s"(sv) : "v"(g), "s"(lds_base) : "memory"); }
#define ATT_WAIT_BAR(N) asm volatile("s_waitcnt vmcnt(" #N ") lgkmcnt(0)\n\ts_barrier" ::: "memory")
#define ATT_MFMA(a, b, c) __builtin_amdgcn_mfma_f32_32x32x16_f16(a, b, c, 0, 0, 0)
__device__ __forceinline__ unsigned cvtpk(float lo, float hi) { return pg8::cvt_pk_f16(lo, hi); }
__device__ __forceinline__ half4 vtr(lds_cptr p) { return __builtin_bit_cast(half4, __builtin_amdgcn_ds_read_tr16_b64_v4i16((ALAS v4i16_t*)p)); }
__device__ __forceinline__ float ex2(float x) { return __builtin_amdgcn_exp2f(x); }

__device__ __forceinline__ void qkt(f32x16& p0, f32x16& p1, lds_cptr Kslot, const half8 (&qr)[4], int r32, int hi) {
    const lds_cptr kb = Kslot + hi * 1024 + r32 * 16;
#pragma unroll
    for (int d0 = 0; d0 < 4; ++d0) {
        const half8 b0 = *(const ALAS half8*)(kb + d0 * 2048);
        const half8 b1 = *(const ALAS half8*)(kb + d0 * 2048 + 512);
        p0 = ATT_MFMA(b0, qr[d0], p0); p1 = ATT_MFMA(b1, qr[d0], p1);
    }
}
__device__ __forceinline__ void pv(f32x16 (&o)[2], lds_cptr Vslot, const half8 (&pa)[4], int lane, int hi) {
    const lds_cptr vb = Vslot + ((lane >> 4) & 1) * 32 + (lane & 3) * 8 + (4 * hi + ((lane & 15) >> 2)) * 64;
#pragma unroll
    for (int d0 = 0; d0 < 2; ++d0)
#pragma unroll
        for (int ks = 0; ks < 4; ++ks) {
            const half4 lo = vtr(vb + d0 * 4096 + ks * 1024), hh = vtr(vb + d0 * 4096 + ks * 1024 + 512);
            const half8 vf = {lo[0], lo[1], lo[2], lo[3], hh[0], hh[1], hh[2], hh[3]};
            o[d0] = ATT_MFMA(pa[ks], vf, o[d0]);
        }
}
__device__ __forceinline__ float rowmax(const f32x16& p0, const f32x16& p1) {
    float a = fmaxf(p0[0], p1[0]);
#pragma unroll
    for (int r = 1; r < 16; ++r) a = fmaxf(a, fmaxf(p0[r], p1[r]));
    auto rr = __builtin_amdgcn_permlane32_swap(__float_as_uint(a), __float_as_uint(a), false, false);
    return fmaxf(__uint_as_float(rr[0]), __uint_as_float(rr[1]));
}
__device__ __forceinline__ float halfsum(float v) {
    auto rr = __builtin_amdgcn_permlane32_swap(__float_as_uint(v), __float_as_uint(v), false, false);
    return __uint_as_float(rr[0]) + __uint_as_float(rr[1]);
}

template <int MASK>
__device__ __forceinline__ void tile_step(f32x16 (&o)[2], float& m, float& l, const half8 (&qr)[4], lds_cptr Kslot, lds_cptr Vslot,
                                          float slope2, float rowc, int koff0, int qoff, bool need_mask, ALAS float* wsf, int lane, int r32, int hi) {
    f32x16 p0, p1;
#pragma unroll
    for (int r = 0; r < 16; ++r) { p0[r] = 0.f; p1[r] = 0.f; }
    qkt(p0, p1, Kslot, qr, r32, hi);
    const float kb = rowc + slope2 * (float)(koff0 + 4 * hi);
#pragma unroll
    for (int r = 0; r < 16; ++r) { const float br = kb + slope2 * (float)((r & 3) + 8 * (r >> 2)); p0[r] += br; p1[r] += br + 32.f * slope2; }
    if (MASK != 0 && need_mask) {
#pragma unroll
        for (int r = 0; r < 16; ++r) { const int ko = koff0 + crow(r, hi);
            if (MASK == 1) { if (ko > qoff) p0[r] = -INFINITY; if (ko + 32 > qoff) p1[r] = -INFINITY; }
            else { if (ko > qoff || qoff - ko >= 128) p0[r] = -INFINITY; if (ko + 32 > qoff || qoff - (ko + 32) >= 128) p1[r] = -INFINITY; } }
    }
    const float rm = rowmax(p0, p1);
    const float mn = fmaxf(m, rm);
    if (__any(mn > m)) {
        const float alpha = ex2(m - mn); l *= alpha; m = mn;
        if (hi == 0) wsf[r32] = alpha;
#pragma unroll
        for (int r = 0; r < 16; ++r) { const float f = wsf[crow(r, hi)]; o[0][r] *= f; o[1][r] *= f; }
    }
    float s = 0.f;
#pragma unroll
    for (int r = 0; r < 16; ++r) { p0[r] = ex2(p0[r] - m); p1[r] = ex2(p1[r] - m); s += p0[r] + p1[r]; }
    l += s;
    half8 pa[4];
    { u32x4 w;
      w.x = cvtpk(p0[0], p0[1]); w.y = cvtpk(p0[2], p0[3]); w.z = cvtpk(p0[4], p0[5]); w.w = cvtpk(p0[6], p0[7]); pa[0] = __builtin_bit_cast(half8, w);
      w.x = cvtpk(p0[8], p0[9]); w.y = cvtpk(p0[10], p0[11]); w.z = cvtpk(p0[12], p0[13]); w.w = cvtpk(p0[14], p0[15]); pa[1] = __builtin_bit_cast(half8, w);
      w.x = cvtpk(p1[0], p1[1]); w.y = cvtpk(p1[2], p1[3]); w.z = cvtpk(p1[4], p1[5]); w.w = cvtpk(p1[6], p1[7]); pa[2] = __builtin_bit_cast(half8, w);
      w.x = cvtpk(p1[8], p1[9]); w.y = cvtpk(p1[10], p1[11]); w.z = cvtpk(p1[12], p1[13]); w.w = cvtpk(p1[14], p1[15]); pa[3] = __builtin_bit_cast(half8, w); }
    pv(o, Vslot, pa, lane, hi);
}

struct Stream { const half_t* K; const half_t* V; int pitch; int t_lo, t_hi; int kbase0; float slope2; };
template <int MASK>
__device__ __forceinline__ void run_stream(f32x16 (&o)[2], float& m, float& l, const half8 (&qr)[4], const Stream& st, float rowc, int qoff, int w_lo, int w_hi, int qmin, int qmax,
                                           char* shm, int lane, int wid, int r32, int hi) {
    const unsigned lds0 = (unsigned)(uintptr_t)shm;
    const lds_cptr shm3 = (lds_cptr)shm;
    ALAS float* wsf = (ALAS float*)(shm3 + L_WS + wid * WS_PER_WAVE);
    const half_t* ksrc = st.K + (long)lane * st.pitch + wid * 8;
    const half_t* vsrc = st.V + (long)(16 * (wid & 3) + (lane >> 2)) * st.pitch + (wid >> 2) * 32 + (lane & 3) * 8;
    const unsigned kdst = lds0 + L_K + wid * 1024, vdst = lds0 + L_V + wid * 1024;
    const long tstride = (long)64 * st.pitch;
#define ATT_DMA(tt, slot) do { glds16(ksrc + (long)(tt) * tstride, (unsigned)__builtin_amdgcn_readfirstlane(kdst + (slot))); glds16(vsrc + (long)(tt) * tstride, (unsigned)__builtin_amdgcn_readfirstlane(vdst + (slot))); } while (0)
    const int nt = st.t_hi - st.t_lo;
    ATT_DMA(st.t_lo, 0);
    if (nt > 1) ATT_DMA(st.t_lo + 1, SLOTB);
    int sl_cur = 0, sl_nn = 2 * SLOTB;
    for (int i = 0; i < nt; ++i) {
        const int tt = st.t_lo + i;
        if (i + 1 < nt) { ATT_WAIT_BAR(2); } else { ATT_WAIT_BAR(0); }
        if (i + 2 < nt) ATT_DMA(tt + 2, sl_nn);
        if (tt >= w_lo && tt < w_hi) {
            const int koff0 = 64 * tt + st.kbase0;
            bool need_mask = false;
            if (MASK == 1) need_mask = (koff0 + 63 > qmin);
            if (MASK == 2) need_mask = (koff0 + 63 > qmin) || (qmax - koff0 >= 128);
            tile_step<MASK>(o, m, l, qr, shm3 + L_K + sl_cur, shm3 + L_V + sl_cur, st.slope2, rowc, koff0, qoff, need_mask, wsf, lane, r32, hi);
        }
        sl_cur = (sl_cur == 2 * SLOTB) ? 0 : sl_cur + SLOTB; sl_nn = (sl_nn == 2 * SLOTB) ? 0 : sl_nn + SLOTB;
    }
    asm volatile("s_waitcnt lgkmcnt(0)\n\ts_barrier" ::: "memory");
#undef ATT_DMA
}

__device__ __forceinline__ void load_q(half8 (&qr)[4], const half_t* qrow, int hi) {
#pragma unroll
    for (int d0 = 0; d0 < 4; ++d0) qr[d0] = *(const half8*)(qrow + d0 * 16 + hi * 8);
}
__device__ __forceinline__ float silu_f(float z) { return z * __builtin_amdgcn_rcpf(1.f + ex2(-1.4426950408889634f * z)); }

__device__ __forceinline__ void stage_o(const f32x16 (&o)[2], float m, float l, ALAS float* wsf, ALAS float* stg, int r32, int hi) {
    const float lt = halfsum(l);
    if (hi == 0) { wsf[r32] = m; wsf[32 + r32] = lt; }
#pragma unroll
    for (int r = 0; r < 16; ++r) { const int row = crow(r, hi); stg[row * ST_PITCH + r32] = o[0][r]; stg[row * ST_PITCH + 32 + r32] = o[1][r]; }
    asm volatile("s_waitcnt lgkmcnt(0)" ::: "memory");
}

struct DenseP {
    const half_t* Q; int qpitch;
    Stream st;
    const half_t* Z; int zpitch;
    half_t* Y;
    float sink2;
    const half_t* PO; const float* PML; int nvalid;
};
template <int MODE>
__device__ __forceinline__ void unit_dense(const DenseP& P, char* shm) {
    const int tid = threadIdx.x, lane = tid & 63, r32 = lane & 31, hi = lane >> 5; const int wid = __builtin_amdgcn_readfirstlane(tid >> 6);
    const lds_cptr shm3 = (lds_cptr)shm;
    ALAS float* wsf = (ALAS float*)(shm3 + L_WS + wid * WS_PER_WAVE);
    ALAS float* stg = (ALAS float*)(shm3 + L_ST + wid * ST_PER_WAVE);
    half8 qr[4]; load_q(qr, P.Q + (long)(wid * 32 + r32) * P.qpitch, hi);
    f32x16 o[2];
#pragma unroll
    for (int r = 0; r < 16; ++r) { o[0][r] = 0.f; o[1][r] = 0.f; }
    float m = NEG_BIG, l = 0.f;
    const int qoff = wid * 32 + r32, qmin = wid * 32, qmax = wid * 32 + 31;
    if (MODE == 2) { m = P.sink2 + P.st.slope2 * (float)qoff; l = (hi == 0) ? 1.f : 0.f; }
    int w_lo = P.st.t_lo, w_hi = P.st.t_hi;
    if (MODE == 1) w_hi = (wid >> 1) + 1;
    if (MODE == 2) { w_lo = (wid >> 1); w_hi = (wid >> 1) + 3; }
    run_stream<MODE>(o, m, l, qr, P.st, 0.f, qoff, w_lo, w_hi, qmin, qmax, shm, lane, wid, r32, hi);
    stage_o(o, m, l, wsf, stg, r32, hi);
#pragma unroll
    for (int i = 0; i < 4; ++i) {
        const int row = i * 8 + (lane >> 3), ch = lane & 7, urow = wid * 32 + row;
        f32x4 a = *(const ALAS f32x4*)(stg + row * ST_PITCH + ch * 8), b = *(const ALAS f32x4*)(stg + row * ST_PITCH + ch * 8 + 4);
        float L = wsf[32 + row];
        if (MODE == 1) {
            const float mo = wsf[row];
            float mk[3], lk[3]; float Mx = mo;
#pragma unroll
            for (int k = 0; k < 3; ++k) { mk[k] = NEG_BIG; lk[k] = 0.f; if (k < P.nvalid) { const float2 ml = *(const float2*)(P.PML + (size_t)k * PML_SLOT + (long)urow * 2); mk[k] = ml.x; lk[k] = ml.y; } Mx = fmaxf(Mx, mk[k]); }
            const float wo = ex2(mo - Mx); a = a * wo; b = b * wo; L *= wo;
#pragma unroll
            for (int k = 0; k < 3; ++k) if (k < P.nvalid) {
                const float wk = lk[k] * ex2(mk[k] - Mx); L += wk;
                const half8 po = *(const half8*)(P.PO + (size_t)k * PO_SLOT + (long)urow * 64 + ch * 8);
                a[0] += wk * (float)po[0]; a[1] += wk * (float)po[1]; a[2] += wk * (float)po[2]; a[3] += wk * (float)po[3];
                b[0] += wk * (float)po[4]; b[1] += wk * (float)po[5]; b[2] += wk * (float)po[6]; b[3] += wk * (float)po[7];
            }
        }
        const float inv = 1.f / L;
        const half8 z = *(const half8*)(P.Z + (long)urow * P.zpitch + ch * 8);
        u32x4 w;
        w.x = cvtpk(a[0] * inv * silu_f((float)z[0]), a[1] * inv * silu_f((float)z[1])); w.y = cvtpk(a[2] * inv * silu_f((float)z[2]), a[3] * inv * silu_f((float)z[3]));
        w.z = cvtpk(b[0] * inv * silu_f((float)z[4]), b[1] * inv * silu_f((float)z[5])); w.w = cvtpk(b[2] * inv * silu_f((float)z[6]), b[3] * inv * silu_f((float)z[7]));
        *(u32x4*)(P.Y + (long)urow * BW + ch * 8) = w;
    }
    asm volatile("s_waitcnt lgkmcnt(0)" ::: "memory");
}

struct SparseP {
    const half_t* Qb; int qpitch;
    Stream st;
    const unsigned short* ent; int nrows;
    int n;
    half_t* PO; float* PML;
};
__device__ __forceinline__ void unit_sparse(const SparseP& P, char* shm) {
    const int tid = threadIdx.x, lane = tid & 63, r32 = lane & 31, hi = lane >> 5; const int wid = __builtin_amdgcn_readfirstlane(tid >> 6);
    const lds_cptr shm3 = (lds_cptr)shm;
    ALAS float* wsf = (ALAS float*)(shm3 + L_WS + wid * WS_PER_WAVE);
    ALAS float* stg = (ALAS float*)(shm3 + L_ST + wid * ST_PER_WAVE);
    const int ridx = wid * 32 + r32; const bool valid = ridx < P.nrows;
    const unsigned e = P.ent[valid ? ridx : 0];
    const int tq = (int)(e >> 2), slot = (int)(e & 3u);
    half8 qr[4]; load_q(qr, P.Qb + (long)tq * P.qpitch, hi);
    f32x16 o[2];
#pragma unroll
    for (int r = 0; r < 16; ++r) { o[0][r] = 0.f; o[1][r] = 0.f; }
    float m = NEG_BIG, l = 0.f;
    const float rowc = -P.st.slope2 * 256.f * (float)((tq >> 8) - P.n);
    run_stream<0>(o, m, l, qr, P.st, rowc, 0, P.st.t_lo, P.st.t_hi, 0, 0, shm, lane, wid, r32, hi);
    stage_o(o, m, l, wsf, stg, r32, hi);
    if (hi == 0) { ((ALAS int*)wsf)[64 + r32] = valid ? (int)e : -1; }
    asm volatile("s_waitcnt lgkmcnt(0)" ::: "memory");
    if (hi == 0 && valid) { float* pm = P.PML + (size_t)slot * PML_SLOT + (long)tq * 2; *(float2*)pm = make_float2(m, wsf[32 + r32]); }
#pragma unroll
    for (int i = 0; i < 4; ++i) {
        const int row = i * 8 + (lane >> 3), ch = lane & 7;
        const int er = ((ALAS int*)wsf)[64 + row];
        if (er >= 0) {
            const f32x4 a = *(const ALAS f32x4*)(stg + row * ST_PITCH + ch * 8), b = *(const ALAS f32x4*)(stg + row * ST_PITCH + ch * 8 + 4);
            const float inv = 1.f / wsf[32 + row];
            u32x4 w; w.x = cvtpk(a[0] * inv, a[1] * inv); w.y = cvtpk(a[2] * inv, a[3] * inv); w.z = cvtpk(b[0] * inv, b[1] * inv); w.w = cvtpk(b[2] * inv, b[3] * inv);
            half_t* po = P.PO + (size_t)(er & 3) * PO_SLOT + (long)(er >> 2) * 64 + ch * 8;
            *(u32x4*)po = w;
        }
    }
    asm volatile("s_waitcnt lgkmcnt(0)" ::: "memory");
}
}
namespace att {
__device__ __forceinline__ int list_off(int n) { return 256 * (63 * n - (n * (n - 1)) / 2); }
constexpr int LIST_PER_BH = 256 * 2016;
struct GateP { const half_t* Q; int qpitch; const float* ksum; int j; unsigned* gcnt; unsigned short* list; };
__device__ __forceinline__ void unit_gate(const GateP& P, char* shm) {
    const int tid = threadIdx.x, lane = tid & 63, r32 = lane & 31, hi = lane >> 5; const int wid = __builtin_amdgcn_readfirstlane(tid >> 6);
    const lds_cptr shm3 = (lds_cptr)shm;
    ALAS int* cnt = (ALAS int*)(shm3 + L_CUM); ALAS int* base = cnt + 64;
    { const int n = tid >> 3, c = tid & 7; const float* kp = P.ksum + (long)n * 768 + c * 8;
      const f32x4 a = *(const f32x4*)kp * (1.f / 256.f), b = *(const f32x4*)(kp + 4) * (1.f / 256.f);
      u32x4 w; w.x = cvtpk(a[0], a[1]); w.y = cvtpk(a[2], a[3]); w.z = cvtpk(b[0], b[1]); w.w = cvtpk(b[2], b[3]);
      *(ALAS u32x4*)(shm3 + L_K + c * 1024 + n * 16) = w; }
    if (tid < 64) cnt[tid] = 0;
    half8 qr[4]; load_q(qr, P.Q + (long)(wid * 32 + r32) * P.qpitch, hi);
    asm volatile("s_waitcnt lgkmcnt(0)\n\ts_barrier" ::: "memory");
    f32x16 p0, p1;
#pragma unroll
    for (int r = 0; r < 16; ++r) { p0[r] = 0.f; p1[r] = 0.f; }
    qkt(p0, p1, shm3 + L_K, qr, r32, hi);
    float v0 = -INFINITY, v1 = -INFINITY, v2 = -INFINITY; int i0 = 255, i1 = 255, i2 = 255;
#define ATT_INS(x_, n_) do { const float x = (x_); const int nn = (n_); \
        if (x > v2 || (x == v2 && nn < i2)) { if (x > v1 || (x == v1 && nn < i1)) { v2 = v1; i2 = i1; if (x > v0 || (x == v0 && nn < i0)) { v1 = v0; i1 = i0; v0 = x; i0 = nn; } else { v1 = x; i1 = nn; } } else { v2 = x; i2 = nn; } } } while (0)
#pragma unroll
    for (int r = 0; r < 16; ++r) { const int n = crow(r, hi); if (n < P.j) ATT_INS(p0[r], n); }
#pragma unroll
    for (int r = 0; r < 16; ++r) { const int n = 32 + crow(r, hi); if (n < P.j) ATT_INS(p1[r], n); }
    { const float w0 = __shfl_xor(v0, 32), w1 = __shfl_xor(v1, 32), w2 = __shfl_xor(v2, 32); const int k0 = __shfl_xor(i0, 32), k1 = __shfl_xor(i1, 32), k2 = __shfl_xor(i2, 32);
      if (k0 != 255) ATT_INS(w0, k0); if (k1 != 255) ATT_INS(w1, k1); if (k2 != 255) ATT_INS(w2, k2); }
#undef ATT_INS
    int rk0 = 0, rk1 = 0, rk2 = 0;
    if (hi == 0) {
        if (i0 != 255) rk0 = __hip_atomic_fetch_add(cnt + i0, 1, __ATOMIC_RELAXED, __HIP_MEMORY_SCOPE_WORKGROUP);
        if (i1 != 255) rk1 = __hip_atomic_fetch_add(cnt + i1, 1, __ATOMIC_RELAXED, __HIP_MEMORY_SCOPE_WORKGROUP);
        if (i2 != 255) rk2 = __hip_atomic_fetch_add(cnt + i2, 1, __ATOMIC_RELAXED, __HIP_MEMORY_SCOPE_WORKGROUP);
    }
    asm volatile("s_waitcnt lgkmcnt(0)\n\ts_barrier" ::: "memory");
    if (tid < 64) { const int c = cnt[tid]; base[tid] = c > 0 ? (int)__hip_atomic_fetch_add(P.gcnt + tid, (unsigned)c, __ATOMIC_RELAXED, __HIP_MEMORY_SCOPE_AGENT) : 0; }
    asm volatile("s_waitcnt vmcnt(0) lgkmcnt(0)\n\ts_barrier" ::: "memory");
    if (hi == 0) {
        const unsigned t = (unsigned)(256 * P.j + wid * 32 + r32);
        if (i0 != 255) P.list[list_off(i0) + base[i0] + rk0] = (unsigned short)((t << 2) | 0u);
        if (i1 != 255) P.list[list_off(i1) + base[i1] + rk1] = (unsigned short)((t << 2) | 1u);
        if (i2 != 255) P.list[list_off(i2) + base[i2] + rk2] = (unsigned short)((t << 2) | 2u);
    }
    asm volatile("s_waitcnt lgkmcnt(0)\n\ts_barrier" ::: "memory");
}
}
constexpr int NWAVES = 8;
constexpr int N_PHASES = 9;
constexpr size_t MiB = 1u << 20;
constexpr size_t WS_CTL = 0, CTL_ZERO_BYTES = 1 * MiB;
constexpr size_t WS_WINA = 2 * MiB;
constexpr size_t WS_WINB = 10 * MiB;
constexpr size_t WS_WOUT = 15 * MiB;
constexpr size_t WS_WMKV = 19 * MiB;
constexpr size_t WS_MEMN = 21 * MiB;
constexpr size_t WS_KVM = 22 * MiB;
constexpr size_t WS_KSUM = 23 * MiB;
constexpr size_t WS_XN = 320 * MiB;
constexpr size_t WS_PROJ = 32 * MiB;
constexpr size_t WS_Y = 256 * MiB;
constexpr size_t WS_X2 = 384 * MiB;
constexpr size_t WS_PO = 320 * MiB;
constexpr size_t WS_PML = 464 * MiB;
constexpr size_t WS_LIST = 474 * MiB;
constexpr size_t WS_END = 512 * MiB;
constexpr int CW_TMO = 0, CW_CODE = 1;
constexpr int CW_BAR = 4096;
constexpr int CW_GCNT = 8192;
constexpr int RING_OFF = 0, RING_BYTES = 131072;
constexpr int LDSCTL_OFF = RING_BYTES, MISC_OFF = LDSCTL_OFF + 320;
constexpr int LDS_BYTES = 147456;
static_assert(MISC_OFF + 128 <= LDS_BYTES, "LDS map");

__device__ __forceinline__ unsigned pk2h(float lo, float hi) { return pg8::cvt_pk_f16(lo, hi); }

struct Frame {
    LAS unsigned char* lds;
    volatile LAS unsigned* MISC;
    gu32* ctl;
    int tid, lane, wave;
    int vcu, G;
};

__device__ __forceinline__ void p0_transpose_item(const float* W, int K, int N, half_t* WT, int row_off, LAS float* scr, int item, int lane) {
    const int nblk = N / 32, kb = item / nblk, nb = item % nblk, k0 = 64 * kb, n0 = 32 * nb;
#pragma unroll 8
    for (int i = 0; i < 32; ++i) { const int kk = 2 * i + (lane >> 5); scr[kk * 33 + (lane & 31)] = W[(size_t)(k0 + kk) * N + n0 + (lane & 31)]; }
    LDS_WAIT(); asm volatile("" ::: "memory");
    const int c = lane & 7;
#pragma unroll
    for (int j = 0; j < 4; ++j) { const int n = (lane >> 3) + 8 * j; const LAS float* s = scr + (8 * c) * 33 + n;
        v4u o; o.x = pk2h(s[0 * 33], s[1 * 33]); o.y = pk2h(s[2 * 33], s[3 * 33]); o.z = pk2h(s[4 * 33], s[5 * 33]); o.w = pk2h(s[6 * 33], s[7 * 33]);
        *(GAS v4u*)(WT + (size_t)(row_off + n0 + n) * K + k0 + 8 * c) = o; }
    LDS_WAIT(); asm volatile("" ::: "memory");
}
__device__ __forceinline__ void rms_row_to_f16(int lane, const float* xrow, const float* g, half_t* orow) {
    const GAS f32x4* xr = (const GAS f32x4*)xrow + lane;
    f32x4 v[4]; float s = 0.f;
#pragma unroll
    for (int j = 0; j < 4; ++j) { v[j] = xr[64 * j]; s += (v[j].x * v[j].x + v[j].y * v[j].y) + (v[j].z * v[j].z + v[j].w * v[j].w); }
    const float rstd = rsqrtf(wave_sum(s) * (1.f / D) + EPS);
    GAS unsigned long long* o8 = (GAS unsigned long long*)orow + lane;
#pragma unroll
    for (int j = 0; j < 4; ++j) { const f32x4 gv = ((const GAS f32x4*)g)[lane + 64 * j]; const f32x4 o = v[j] * rstd * gv;
        o8[64 * j] = (unsigned long long)pk2h(o.x, o.y) | ((unsigned long long)pk2h(o.z, o.w) << 32); }
}

struct Args { const float* in[10]; float* out; unsigned char* ws; int ph_lo, ph_hi, flags, pad; };
struct OneUnit { int pm, pn;
    __device__ __forceinline__ bool next(int i, pg8::Unit& u) const { if (i > 0) return false; u.pm = pm; u.pn = pn; return true; }
    __device__ __forceinline__ void a_ready(const pg8::Unit&) const {}
    __device__ __forceinline__ void done(const pg8::Unit&) const {} };
constexpr float LOG2E = 1.4426950408889634f;

__global__ void __launch_bounds__(NWAVES * 64, 2) mk_fwd(Args args) {
    extern __shared__ __attribute__((aligned(16))) unsigned char lds[];
    Frame F;
    F.lds = (LAS unsigned char*)lds;
    F.MISC = (volatile LAS unsigned*)(F.lds + MISC_OFF);
    F.tid = threadIdx.x; F.lane = F.tid & 63; F.wave = __builtin_amdgcn_readfirstlane(F.tid >> 6);
    F.G = gridDim.x; { const int bx = blockIdx.x; F.vcu = (F.G % 8 == 0) ? (bx % 8) * (F.G / 8) + bx / 8 : bx; }
    unsigned char* ws = args.ws;
    F.ctl = (gu32*)(ws + WS_CTL);
    const float* x = args.in[0]; const float* mem = args.in[1]; const float* norm_g = args.in[2]; const float* w_in_a = args.in[3]; const float* w_in_b = args.in[4];
    const float* w_mem_kv = args.in[6]; const float* w_out = args.in[7]; const float* mem_norm_g = args.in[8];
    half_t* WinA_t = (half_t*)(ws + WS_WINA); half_t* WinB_t = (half_t*)(ws + WS_WINB); half_t* Wout_t = (half_t*)(ws + WS_WOUT); half_t* Wmkv_t = (half_t*)(ws + WS_WMKV);
    half_t* MEMN = (half_t*)(ws + WS_MEMN); float* KSUM = (float*)(ws + WS_KSUM); half_t* KVM = (half_t*)(ws + WS_KVM);
    unsigned short* LIST = (unsigned short*)(ws + WS_LIST);
    half_t* PO = (half_t*)(ws + WS_PO); float* PML = (float*)(ws + WS_PML);
    const float* sinks_b = args.in[5];
    half_t* XN = (half_t*)(ws + WS_XN); half_t* PROJ = (half_t*)(ws + WS_PROJ); half_t* Y = (half_t*)(ws + WS_Y); float* X2 = (float*)(ws + WS_X2);
    for (int u = F.tid; u < (LDS_BYTES - LDSCTL_OFF) / 4; u += NWAVES * 64) ((LAS unsigned*)(F.lds + LDSCTL_OFF))[u] = 0u;
    __syncthreads();
    const bool one_launch = (args.ph_hi - args.ph_lo) > 1;
    XcdBarrier bar; bar.bar = (unsigned*)(F.ctl + CW_BAR); bar.x = 0; bar.st = nullptr;
    if (one_launch) bar = xcd_barrier_post((unsigned*)(F.ctl + CW_BAR), F.MISC + 8);
#define GRID_BAR() do { xcd_barrier(bar); } while (0)
    const int lo = args.ph_lo, hi = args.ph_hi;
#define IN(k) (lo <= (k) && (k) < hi)
#define BOTH(k) (IN(k) && IN((k) + 1))

    if (IN(0)) {
        LAS float* scr = (LAS float*)(F.lds + RING_OFF + F.wave * 16384);
        const int gw = F.vcu * NWAVES + F.wave, NGW = F.G * NWAVES;
        constexpr int I_A = (D / 64) * (INA / 32), I_B = (D / 64) * (INB / 32), I_O = (D / 64) * (D / 32), I_M = (D / 64) * (512 / 32);
        constexpr int NITEMS = I_A + I_B + 2 * I_O + 2 * I_M;
        for (int it = gw; it < NITEMS; it += NGW) {
            int r = it;
            if (r < I_A) { p0_transpose_item(w_in_a, D, INA, WinA_t, 0, scr, r, F.lane); continue; } r -= I_A;
            if (r < I_B) { p0_transpose_item(w_in_b, D, INB, WinB_t, 0, scr, r, F.lane); continue; } r -= I_B;
            if (r < I_O) { p0_transpose_item(w_out, D, D, Wout_t, 0, scr, r, F.lane); continue; } r -= I_O;
            if (r < I_O) { p0_transpose_item(w_out + (size_t)D * D, D, D, Wout_t + (size_t)D * D, 0, scr, r, F.lane); continue; } r -= I_O;
            if (r < I_M) { p0_transpose_item(w_mem_kv, D, 512, Wmkv_t, 0, scr, r, F.lane); continue; } r -= I_M;
            p0_transpose_item(w_mem_kv + (size_t)D * 512, D, 512, Wmkv_t, 512, scr, r, F.lane);
        }
        for (int m = gw; m < M; m += NGW) rms_row_to_f16(F.lane, x + (size_t)m * D, norm_g, XN + (size_t)m * D);
        for (int m = gw; m < NB * MEML; m += NGW) rms_row_to_f16(F.lane, mem + (size_t)m * D, mem_norm_g, MEMN + (size_t)m * D);
        for (int i = blockIdx.x * (NWAVES * 64) + F.tid; i < NB * NBLK * AW / 4; i += F.G * NWAVES * 64) ((GAS f32x4*)KSUM)[i] = (f32x4){0.f, 0.f, 0.f, 0.f};
        if (BOTH(0)) GRID_BAR();
    }
    if (IN(1)) {
        pg8::Gemm g{XN, WinA_t, M, INA, D}; pg8::StaticOrder So; So.init(M, INA, F.G, (int)blockIdx.x);
        pg8::EpiF16 E{PROJ, INA, 0x207u, 0x38u, KSUM, 3};
        pg8::gemm_phase<pg8::EpiF16, pg8::StaticOrder, true, true>(F.lds + RING_OFF, g, So, E);
        if (BOTH(1)) GRID_BAR();
    }

    if (IN(2)) {
        if (blockIdx.x < 8) {
            pg8::Gemm g{MEMN, Wmkv_t, NB * MEML, 1024, D}; OneUnit So{(int)(blockIdx.x >> 2), (int)(blockIdx.x & 3)};
            pg8::EpiF16 E{KVM, KVP, 0u, 0u, KSUM, 0};
            pg8::gemm_phase<pg8::EpiF16, OneUnit, false, true>(F.lds + RING_OFF, g, So, E);
        }
        for (int u = F.vcu; u < NB * NH * 63; u += F.G) {
            const int bh = u / 63, j = 1 + u % 63, b = bh / NH, h = bh % NH;
            att::GateP P{PROJ + ((size_t)b * S + 256 * j) * INA + A_Q + h * 64, INA, KSUM + (size_t)b * NBLK * AW + h * 64, j, (unsigned*)(F.ctl + CW_GCNT) + bh * 64, LIST + (size_t)bh * att::LIST_PER_BH};
            att::unit_gate(P, (char*)lds + RING_OFF);
        }
        if (BOTH(2)) GRID_BAR();
    }
    if (IN(3)) {
        ALAS int* cum = (ALAS int*)((att::lds_cptr)lds + att::L_CUM);
        const unsigned* gc = (const unsigned*)(F.ctl + CW_GCNT);
        if (F.wave == 0) {
            int sum = 0;
#pragma unroll
            for (int k = 0; k < 24; ++k) sum += ((int)gc[24 * F.lane + k] + 255) >> 8;
            int incl = sum;
#pragma unroll
            for (int o = 1; o < 64; o <<= 1) { const int t = __shfl_up(incl, o); if (F.lane >= o) incl += t; }
            int run = incl - sum;
#pragma unroll
            for (int k = 0; k < 24; ++k) { run += ((int)gc[24 * F.lane + k] + 255) >> 8; cum[24 * F.lane + k] = run; }
        }
        __syncthreads();
        const int T = cum[NB * NH * 64 - 1];
        const int s_lo = (int)((long)F.vcu * T / F.G), s_hi = (int)((long)(F.vcu + 1) * T / F.G);
        int it = 0;
        for (int s = s_lo; s < s_hi; ++s) {
            while (cum[it] <= s) ++it;
            const int c = s - (it ? cum[it - 1] : 0); const int cntv = (int)gc[it];
            const int bh = it >> 6, n = it & 63, b = bh / NH, h = bh % NH;
            att::SparseP P;
            P.Qb = PROJ + (size_t)b * S * INA + A_Q + h * 64; P.qpitch = INA;
            P.st.K = PROJ + ((size_t)b * S + 256 * n) * INA + A_K + h * 64; P.st.V = PROJ + ((size_t)b * S + 256 * n) * INA + A_V + h * 64; P.st.pitch = INA;
            P.st.t_lo = 0; P.st.t_hi = 4; P.st.kbase0 = 0; P.st.slope2 = slope_of(h) * LOG2E;
            P.ent = LIST + (size_t)bh * att::LIST_PER_BH + att::list_off(n) + 256 * c; P.nrows = (cntv - 256 * c) < 256 ? (cntv - 256 * c) : 256; P.n = n;
            P.PO = PO + (size_t)bh * S * 64; P.PML = PML + (size_t)bh * S * 2;
            att::unit_sparse(P, (char*)lds + RING_OFF);
        }
        if (BOTH(3)) GRID_BAR();
    }
    if (IN(4)) {
        for (int u = F.vcu; u < 2048; u += F.G) {
            att::DenseP P;
            if (u < 1536) {
                if (args.flags & 1) continue;
                const int bh = u >> 6, j = u & 63, b = bh / NH, h = bh % NH; const size_t row0 = (size_t)b * S + 256 * j;
                P.Q = PROJ + row0 * INA + A_Q + h * 64; P.qpitch = INA;
                P.st.K = PROJ + row0 * INA + A_K + h * 64; P.st.V = PROJ + row0 * INA + A_V + h * 64; P.st.pitch = INA; P.st.t_lo = 0; P.st.t_hi = 4; P.st.kbase0 = 0; P.st.slope2 = slope_of(h) * LOG2E;
                P.Z = PROJ + row0 * INA + A_Z + h * 64; P.zpitch = INA; P.Y = Y + row0 * BW + h * 64; P.sink2 = 0.f; P.nvalid = j < 3 ? j : 3;
                P.PO = PO + ((size_t)bh * S + 256 * j) * 64; P.PML = PML + ((size_t)bh * S + 256 * j) * 2;
                att::unit_dense<1>(P, (char*)lds + RING_OFF);
            } else {
                const int v = u - 1536, b = v >> 8, hm = (v >> 6) & 3, rb = v & 63; const size_t row0 = (size_t)b * S + 256 * rb;
                P.Q = PROJ + row0 * INA + A_QM + hm * 64; P.qpitch = INA;
                P.st.K = KVM + (size_t)b * MEML * KVP + hm * 64; P.st.V = P.st.K + 256; P.st.pitch = KVP; P.st.t_lo = 0; P.st.t_hi = 4; P.st.kbase0 = 0; P.st.slope2 = 0.f;
                P.Z = PROJ + row0 * INA + A_Z + AW + hm * 64; P.zpitch = INA; P.Y = Y + row0 * BW + AW + hm * 64; P.sink2 = 0.f; P.nvalid = 0;
                P.PO = nullptr; P.PML = nullptr;
                att::unit_dense<0>(P, (char*)lds + RING_OFF);
            }
        }
        if (BOTH(4)) GRID_BAR();
    }
    if (IN(5)) {
        pg8::Gemm g{Y, Wout_t, M, D, D}; pg8::StaticOrder So; So.init(M, D, F.G, (int)blockIdx.x);
        pg8::EpiResF32 E{x, args.out, D};
        pg8::gemm_phase<pg8::EpiResF32, pg8::StaticOrder, true, true>(F.lds + RING_OFF, g, So, E);
        if (BOTH(5)) GRID_BAR();
    }
    if (IN(6)) {
        pg8::Gemm g{XN, WinB_t, M, INB, D}; pg8::StaticOrder So; So.init(M, INB, F.G, (int)blockIdx.x);
        pg8::EpiF16 E{PROJ, INB, 0x17u, 0u, KSUM, 0};
        pg8::gemm_phase<pg8::EpiF16, pg8::StaticOrder, true, true>(F.lds + RING_OFF, g, So, E);
        if (BOTH(6)) GRID_BAR();
    }

    if (IN(7)) {
        for (int u = F.vcu; u < 2048; u += F.G) {
            att::DenseP P;
            P.PO = nullptr; P.PML = nullptr;
            P.nvalid = 0;
            if (u < 1536) {
                const int g6 = u % 6, rb = (u / 6) & 63, bk = u / 384, b = bk >> 1, kvh = bk & 1, h = kvh * 6 + g6; const size_t row0 = (size_t)b * S + 256 * rb;
                P.Q = PROJ + row0 * INB + B_Q + h * 64; P.qpitch = INB;
                P.st.K = PROJ + ((long)row0 - 128) * INB + B_K + kvh * 64; P.st.V = PROJ + ((long)row0 - 128) * INB + B_V + kvh * 64; P.st.pitch = INB;
                P.st.t_lo = rb == 0 ? 2 : 0; P.st.t_hi = 6; P.st.kbase0 = -128; P.st.slope2 = slope_of(h) * LOG2E;
                P.Z = PROJ + row0 * INB + B_Z + h * 64; P.zpitch = INB; P.Y = Y + row0 * BW + h * 64; P.sink2 = sinks_b[h] * LOG2E;
                att::unit_dense<2>(P, (char*)lds + RING_OFF);
            } else {
                const int v = u - 1536, b = v >> 8, hm = (v >> 6) & 3, rb = v & 63; const size_t row0 = (size_t)b * S + 256 * rb;
                P.Q = PROJ + row0 * INB + B_QM + hm * 64; P.qpitch = INB;
                P.st.K = KVM + (size_t)b * MEML * KVP + 512 + hm * 64; P.st.V = P.st.K + 256; P.st.pitch = KVP; P.st.t_lo = 0; P.st.t_hi = 4; P.st.kbase0 = 0; P.st.slope2 = 0.f;
                P.Z = PROJ + row0 * INB + B_Z + AW + hm * 64; P.zpitch = INB; P.Y = Y + row0 * BW + AW + hm * 64; P.sink2 = 0.f;
                att::unit_dense<0>(P, (char*)lds + RING_OFF);
            }
        }
        if (BOTH(7)) GRID_BAR();
    }
    if (IN(8)) {
        pg8::Gemm g{Y, Wout_t + (size_t)D * D, M, D, D}; pg8::StaticOrder So; So.init(M, D, F.G, (int)blockIdx.x);
        pg8::EpiResF32 E{args.out, X2, D};
        pg8::gemm_phase<pg8::EpiResF32, pg8::StaticOrder, true, true>(F.lds + RING_OFF, g, So, E);
    }
#undef IN
#undef BOTH
}

extern "C" void kernel_launch(void* const* d_in, const int* in_sizes, int n_in, void* d_out, int out_size, void* d_ws, size_t ws_size, hipStream_t stream) {
    static int grid = 0;
    if (grid == 0) {
        if (n_in != 10 || in_sizes[0] != M * D || out_size != M * D || ws_size < WS_END) { fprintf(stderr, "kernel_launch: unexpected shapes / workspace (%zu)\n", ws_size); grid = -1; return; }
        int dev = 0, cus = 0;
        if (hipGetDevice(&dev) != hipSuccess || hipDeviceGetAttribute(&cus, hipDeviceAttributeMultiprocessorCount, dev) != hipSuccess) { grid = -1; return; }
        if (hipFuncSetAttribute((const void*)mk_fwd, hipFuncAttributeMaxDynamicSharedMemorySize, LDS_BYTES) != hipSuccess) { fprintf(stderr, "kernel_launch: hipFuncSetAttribute failed\n"); grid = -1; return; }
        (void)hipGetLastError();
        grid = cus;
    }
    if (grid < 0) return;
    const float* x = (const float*)d_in[0]; const float* sinks_b = (const float*)d_in[5]; const float* w_mem_kv = (const float*)d_in[6];
    const float* norm_g = (const float*)d_in[2]; const float* final_norm_g = (const float*)d_in[9];
    unsigned char* ws = (unsigned char*)d_ws; float* out = (float*)d_out;
    half_t* MEMN = (half_t*)(ws + WS_MEMN); half_t* KVM = (half_t*)(ws + WS_KVM); float* KSUM = (float*)(ws + WS_KSUM);
    half_t* XN = (half_t*)(ws + WS_XN); half_t* PROJ = (half_t*)(ws + WS_PROJ); half_t* Y = (half_t*)(ws + WS_Y); float* X2 = (float*)(ws + WS_X2);
    (void)hipMemsetAsync(ws + WS_CTL, 0, CTL_ZERO_BYTES, stream);
    Args a{};
    for (int i = 0; i < 10; ++i) a.in[i] = (const float*)d_in[i];
    a.out = out; a.ws = ws;
#define MK(lo_, hi_, fl_) do { a.ph_lo = (lo_); a.ph_hi = (hi_); a.flags = (fl_); hipLaunchKernelGGL(mk_fwd, dim3(grid), dim3(NWAVES * 64), LDS_BYTES, stream, a); } while (0)
    MK(0, 1, 0);
    MK(1, 2, 0);
    MK(2, 3, 0);
    MK(3, 4, 0);
    MK(4, 5, 0);
    MK(5, 6, 0);
    k_rmsnorm<true><<<M / 4, 256, 0, stream>>>(out, norm_g + D, XN, M);
    MK(6, 7, 0);
    MK(7, 8, 0);
    MK(8, 9, 0);
    k_rmsnorm<false><<<M / 4, 256, 0, stream>>>(X2, final_norm_g, out, M);
}
```
